# Optimizing an MI355X kernel written in HIP

```python
import jax, jax.numpy as jnp
from jax import lax
import numpy as np

D_MODEL = 2048
BATCH = 2
SEQ = 4096
DEPTH = 1

CHUNK = 64
CONV_W = 3
D_CONV = D_MODEL
N_HEADS = 16
N_KV_HEADS = 4
HEAD_DIM = 128
GROUP = N_HEADS // N_KV_HEADS
D_ATTN = N_HEADS * HEAD_DIM
D_KV = N_KV_HEADS * HEAD_DIM
IDX_HEADS = 16
IDX_DIM = 64
IDX_W_SCALE = (IDX_HEADS * IDX_DIM) ** -0.5
TOPK_MAX = 256
Q_BLOCK = 128
D_FF = 5632
ALPHA = (2.0 * DEPTH) ** 0.25
BETA = (8.0 * DEPTH) ** -0.25
LN_EPS = 1e-5
N_MOD = 6

_IN_SIZES = (D_CONV, D_CONV, D_CONV,
             D_ATTN, D_KV, D_KV,
             IDX_HEADS * IDX_DIM, IDX_DIM, IDX_HEADS,
             D_MODEL, D_MODEL)
D_IN = sum(_IN_SIZES)

kernel_name = "hybrid_shortconv_dsa_convffn_deepnorm_adaln"


def layer_norm(x, g, b):
    xf = x.astype(jnp.float32)
    mu = jnp.mean(xf, axis=-1, keepdims=True)
    var = jnp.mean(jnp.square(xf - mu), axis=-1, keepdims=True)
    y = (xf - mu) * lax.rsqrt(var + LN_EPS)
    return (y * g.astype(jnp.float32) + b.astype(jnp.float32)).astype(x.dtype)


def causal_dwconv(h, w):
    S = h.shape[1]
    hp = jnp.pad(h, ((0, 0), (CONV_W - 1, 0), (0, 0)))
    out = hp[:, 0:S] * w[0]
    for j in range(1, CONV_W):
        out = out + hp[:, j:j + S] * w[j]
    return out


def dsa_attention(q, k, v, q_idx, k_idx, w_idx):
    B, S = q.shape[0], q.shape[1]
    topk = min(TOPK_MAX, S // 4)
    nblk = S // Q_BLOCK
    key_pos = jnp.arange(S)
    f32 = jnp.float32
    k_idx32 = k_idx.astype(f32)

    def to_blocks(a):
        return jnp.swapaxes(a.reshape((B, nblk, Q_BLOCK) + a.shape[2:]), 0, 1)

    def block_fn(args):
        blk, qb, qib, wb = args
        q_pos = blk * Q_BLOCK + jnp.arange(Q_BLOCK)
        limit = (q_pos // CHUNK + 1) * CHUNK
        admissible = key_pos[None, :] < limit[:, None]
        dots = jnp.einsum('bqhd,bsd->bqhs', qib.astype(f32), k_idx32)
        score = jnp.einsum('bqh,bqhs->bqs', wb.astype(f32), jax.nn.relu(dots))
        score = jnp.where(admissible[None], score, -jnp.inf)
        _, sel = lax.top_k(score, topk)
        valid = sel < limit[None, :, None]
        ks = jax.vmap(lambda kb, ib: kb[ib])(k, sel)
        vs = jax.vmap(lambda vb, ib: vb[ib])(v, sel)
        qg = qb.reshape(B, Q_BLOCK, N_KV_HEADS, GROUP, HEAD_DIM)
        logits = jnp.einsum('bqngd,bqknd->bqngk', qg.astype(f32), ks.astype(f32)) * (HEAD_DIM ** -0.5)
        logits = jnp.where(valid[:, :, None, None, :], logits, -jnp.inf)
        p = jax.nn.softmax(logits, axis=-1)
        o = jnp.einsum('bqngk,bqknd->bqngd', p, vs.astype(f32))
        return o.reshape(B, Q_BLOCK, D_ATTN).astype(q.dtype)

    out = lax.map(block_fn, (jnp.arange(nblk), to_blocks(q), to_blocks(q_idx), to_blocks(w_idx)))
    return jnp.swapaxes(out, 0, 1).reshape(B, S, D_ATTN)


def setup_inputs(seed: int = 0) -> dict:
    key = jax.random.key(seed)
    ks = jax.random.split(key, 20)
    f32 = jnp.float32
    L = DEPTH

    def nrm(k, shape, scale):
        return jax.random.normal(k, shape, f32) * scale

    return {
        "x": nrm(ks[0], (BATCH, SEQ, D_MODEL), 1.0),
        "c": nrm(ks[1], (BATCH, D_MODEL), 1.0),
        "w_cond": nrm(ks[2], (L, D_MODEL, N_MOD * D_MODEL), 0.2 * D_MODEL ** -0.5),
        "b_cond": nrm(ks[3], (L, N_MOD * D_MODEL), 0.01),
        "w_in": nrm(ks[4], (L, D_MODEL, D_IN), D_MODEL ** -0.5),
        "conv_a": nrm(ks[5], (L, CONV_W, D_CONV), CONV_W ** -0.5),
        "idx_kn_g": 1.0 + nrm(ks[6], (L, IDX_DIM), 0.02),
        "idx_kn_b": nrm(ks[7], (L, IDX_DIM), 0.02),
        "w_a": nrm(ks[8], (L, D_CONV, D_MODEL), D_CONV ** -0.5),
        "w_b": nrm(ks[9], (L, D_ATTN, D_MODEL), D_ATTN ** -0.5),
        "w_o": nrm(ks[10], (L, D_MODEL, D_MODEL), BETA * D_MODEL ** -0.5),
        "ln1_g": 1.0 + nrm(ks[11], (L, D_MODEL), 0.02),
        "ln1_b": nrm(ks[12], (L, D_MODEL), 0.02),
        "w_up": nrm(ks[13], (L, D_MODEL, 2 * D_FF), D_MODEL ** -0.5),
        "conv_f": nrm(ks[14], (L, CONV_W, D_FF), CONV_W ** -0.5),
        "w_down": nrm(ks[15], (L, D_FF, D_MODEL), BETA * D_FF ** -0.5),
        "ln2_g": 1.0 + nrm(ks[16], (L, D_MODEL), 0.02),
        "ln2_b": nrm(ks[17], (L, D_MODEL), 0.02),
    }


def reference(x, c, w_cond, b_cond, w_in, conv_a, idx_kn_g, idx_kn_b, w_a, w_b, w_o,
              ln1_g, ln1_b, w_up, conv_f, w_down, ln2_g, ln2_b):
    B, S, D = x.shape
    offsets = [int(o) for o in np.cumsum(_IN_SIZES)[:-1]]
    c_act = jax.nn.silu(c)
    for l in range(DEPTH):
        mod = (jnp.einsum('bd,de->be', c_act, w_cond[l]) + b_cond[l])[:, None, :]
        sh_m, sc_m, g_m, sh_f, sc_f, g_f = jnp.split(mod, N_MOD, axis=-1)

        u = x * (1.0 + sc_m) + sh_m
        proj = jnp.einsum('bsd,de->bse', u, w_in[l])
        cb, cc, ch, q, k, v, qi, ki, wi, ga, gb = jnp.split(proj, offsets, axis=-1)

        y_a = cb * causal_dwconv(cc * ch, conv_a[l])

        ki = layer_norm(ki, idx_kn_g[l], idx_kn_b[l])
        y_b = dsa_attention(q.reshape(B, S, N_HEADS, HEAD_DIM),
                            k.reshape(B, S, N_KV_HEADS, HEAD_DIM),
                            v.reshape(B, S, N_KV_HEADS, HEAD_DIM),
                            qi.reshape(B, S, IDX_HEADS, IDX_DIM),
                            ki,
                            wi * IDX_W_SCALE)

        merged = (jax.nn.sigmoid(ga) * jnp.einsum('bsc,cd->bsd', y_a, w_a[l])
                  + jax.nn.sigmoid(gb) * jnp.einsum('bsc,cd->bsd', y_b, w_b[l]))
        mix_out = jnp.einsum('bsd,de->bse', merged, w_o[l])
        x = layer_norm(ALPHA * x + (1.0 + g_m) * mix_out, ln1_g[l], ln1_b[l])

        u = x * (1.0 + sc_f) + sh_f
        h_act, h_gate = jnp.split(jnp.einsum('bsd,df->bsf', u, w_up[l]), 2, axis=-1)
        h_act = causal_dwconv(h_act, conv_f[l])
        y = jnp.einsum('bsf,fd->bsd', jax.nn.gelu(h_act) * h_gate, w_down[l])
        x = layer_norm(ALPHA * x + (1.0 + g_f) * y, ln2_g[l], ln2_b[l])
    return x
```

```cpp
#include <hip/hip_runtime.h>
#include <hip/hip_cooperative_groups.h>
#include <cstdio>
namespace cg = cooperative_groups;

#define LAS __attribute__((address_space(3)))
typedef unsigned short bf16_t;
typedef short bf16x8 __attribute__((ext_vector_type(8)));
typedef float f32x4 __attribute__((ext_vector_type(4)));
typedef float f32x16 __attribute__((ext_vector_type(16)));
typedef unsigned u32x4 __attribute__((ext_vector_type(4)));
typedef unsigned u32x2 __attribute__((ext_vector_type(2)));

constexpr int NB = 2, SEQ = 4096, DM = 2048, MT = NB * SEQ;
constexpr int NPROJ = 14592;
constexpr int DFF = 5632, NMOD = 12288;
constexpr float ALPHA = 1.189207115002721f;
constexpr float LN_EPS = 1e-5f;
constexpr int NWAVES = 8, NTHR = 512;
constexpr int LDS_BYTES = 147456;

constexpr size_t al256(size_t x) { return (x + 255) & ~(size_t)255; }
constexpr size_t WS_PART = 1u << 20;
constexpr size_t WS_MOD  = WS_PART + al256((size_t)8 * 2 * NMOD * 4);
constexpr size_t WS_WIN  = WS_MOD + al256((size_t)2 * NMOD * 4);
constexpr size_t WS_WA   = WS_WIN + (size_t)NPROJ * DM * 2;
constexpr size_t WS_WB   = WS_WA + (size_t)DM * DM * 2;
constexpr size_t WS_WO   = WS_WB + (size_t)DM * DM * 2;
constexpr size_t WS_WUP  = WS_WO + (size_t)DM * DM * 2;
constexpr size_t WS_WD   = WS_WUP + (size_t)2 * DFF * DM * 2;
constexpr size_t WS_U    = WS_WD + (size_t)DM * DFF * 2;
constexpr size_t ACT     = (size_t)MT * DM * 2;
constexpr size_t WS_CB   = WS_U + ACT;
constexpr size_t WS_CC   = WS_CB + ACT;
constexpr size_t WS_CH   = WS_CC + ACT;
constexpr size_t WS_Q    = WS_CH + ACT;
constexpr size_t WS_GA   = WS_Q + ACT;
constexpr size_t WS_GB   = WS_GA + ACT;
constexpr size_t WS_K    = WS_GB + ACT;
constexpr size_t WS_V    = WS_K + (size_t)MT * 512 * 2;
constexpr size_t WS_VT   = WS_V + (size_t)MT * 512 * 2;
constexpr size_t WS_QI   = WS_VT + (size_t)MT * 512 * 2;
constexpr size_t WS_KW   = WS_QI + (size_t)MT * 1024 * 2;
constexpr size_t WS_KIB  = WS_KW + (size_t)MT * 256 * 2;
constexpr size_t WS_WIF  = WS_KIB + (size_t)MT * 64 * 2;
constexpr size_t WS_MASK = WS_WIF + (size_t)MT * 16 * 4;
constexpr size_t WS_END  = WS_MASK + (size_t)MT * 64 * 8;
constexpr size_t WS_Z    = WS_CC;
constexpr size_t WS_HA   = WS_CB;
constexpr size_t WS_HG   = WS_CB + (size_t)MT * DFF * 2;
constexpr size_t WS_Z2   = WS_CB;
static_assert(WS_HG + (size_t)MT * DFF * 2 <= WS_K, "up-proj overlay fits in the proj region");

__device__ __forceinline__ unsigned cvt_pk_bf16(float lo, float hi) { unsigned r; asm volatile("v_cvt_pk_bf16_f32 %0, %1, %2" : "=v"(r) : "v"(lo), "v"(hi)); return r; }
__device__ __forceinline__ float bflo(unsigned w) { return __uint_as_float(w << 16); }
__device__ __forceinline__ float bfhi(unsigned w) { return __uint_as_float(w & 0xffff0000u); }
__device__ __forceinline__ float sigmoidf_(float g) { return __builtin_amdgcn_rcpf(1.0f + __expf(-g)); }
__device__ __forceinline__ float wave_sum(float v) {
#pragma unroll
    for (int o = 1; o < 64; o <<= 1) v += __shfl_xor(v, o);
    return v;
}

namespace pg8 {
constexpr int BM = 256, BK = 64, HALF = 128, HTB = HALF * BK * 2, STAGE_BYTES = 8 * HTB, NXCD = 8, WGM = 8;
__host__ __device__ __forceinline__ int lds_byte(int r, int c) { const int st = (r >> 4) * 2 + (c >> 5), rr = r & 15, cc = c & 31, ob = rr * 64 + cc * 2; return st * 1024 + (ob ^ (((ob >> 9) & 1) << 5)); }
__host__ __device__ __forceinline__ void stage_rc(int b, int& R, int& C) { const int st = b / 1024, sb = b % 1024, swz = sb ^ (((sb >> 9) & 1) << 5); R = (st >> 1) * 16 + swz / 64; C = (st & 1) * 32 + (swz % 64) / 2; }
__host__ __device__ __forceinline__ int perm32(int rho) { const int n = rho >> 4, i = rho & 15; return 8 * (i >> 2) + 4 * n + (i & 3); }
struct Unit { int pm, pn; };
struct Gemm { const bf16_t* A; const bf16_t* Bt; int M, N, K; };
struct StaticOrder {
    int nM, nN, nwg, G, c;
    __host__ __device__ void init(int M, int N, int G_, int c_) { nM = M / BM; nN = N / BM; nwg = nM * nN; G = G_; c = c_; }
    __host__ __device__ bool next(int i, Unit& u) const {
        const long L = (long)i * G + c; if (L >= nwg) return false;
        int wgid = (int)L; { const int q = nwg / NXCD, r = nwg % NXCD, xcd = wgid % NXCD, off = wgid / NXCD; wgid = (xcd < r ? xcd * (q + 1) : r * (q + 1) + (xcd - r) * q) + off; }
        const int nig = WGM * nN, gid = wgid / nig, fm = gid * WGM, gsz = (nM - fm) < WGM ? (nM - fm) : WGM;
        u.pm = fm + ((wgid % nig) % gsz); u.pn = (wgid % nig) / gsz; return true;
    }
};
template <class Epi>
__device__ __forceinline__ void gemm_phase(LAS unsigned char* lds, const Gemm g, const StaticOrder& S, const Epi& E) {
    const int tid = threadIdx.x, wid = __builtin_amdgcn_readfirstlane(tid >> 6), lane = tid & 63, wr = wid >> 2, wc = wid & 3, fr = lane & 15, fq = lane >> 4;
    const int K = g.K, nt = K / BK;
    unsigned voffA[2], voffB[2];
#pragma unroll
    for (int i = 0; i < 2; ++i) { int R, C; stage_rc(tid * 16 + i * 8192, R, C); const int Rb = (R & ~31) + perm32(R & 31);
        voffA[i] = (unsigned)(R * K + C) * 2u; voffB[i] = (unsigned)(Rb * K + C) * 2u; }
    const size_t kstep = (size_t)(BK * 2);
    const size_t hstep = (size_t)HALF * K * 2;
    const size_t tstep = 2 * hstep;
    const unsigned ldsw = (unsigned)wid * 1024u;
    const int aoff = lds_byte(wr * 64 + fr, fq * 8), boff = lds_byte(wc * 32 + fr, fq * 8);
#define PG8_SA(b, h) (((b) * 2 + (h)) * HTB)
#define PG8_SB(b, h) ((4 + (b) * 2 + (h)) * HTB)
#define PG8_STAGE(bufoff, gbase, voff) do { _Pragma("unroll") for (int _i = 0; _i < 2; ++_i) \
        __builtin_amdgcn_global_load_lds((const unsigned*)((const char*)(gbase) + (voff)[_i]), (LAS unsigned*)(lds + (bufoff) + ldsw + _i * 8192), 16, 0, 0); } while (0)
#define PG8_LDA(dst, b, h) do { _Pragma("unroll") for (int m = 0; m < 4; ++m) _Pragma("unroll") for (int k = 0; k < 2; ++k) dst[m][k] = *(const LAS bf16x8*)(lds + PG8_SA(b, h) + aoff + m * 2048 + k * 1024); } while (0)
#define PG8_LDB(dst, b, h) do { _Pragma("unroll") for (int n = 0; n < 2; ++n) _Pragma("unroll") for (int k = 0; k < 2; ++k) dst[n][k] = *(const LAS bf16x8*)(lds + PG8_SB(b, h) + boff + n * 2048 + k * 1024); } while (0)
#define PG8_MMA(ai, bj, At, Bt) do { __builtin_amdgcn_s_setprio(1); _Pragma("unroll") for (int m = 0; m < 4; ++m) _Pragma("unroll") for (int n = 0; n < 2; ++n) _Pragma("unroll") for (int k = 0; k < 2; ++k) \
        acc[ai][bj][m][n] = __builtin_amdgcn_mfma_f32_16x16x32_bf16(Bt[n][k], At[m][k], acc[ai][bj][m][n], 0, 0, 0); __builtin_amdgcn_s_setprio(0); } while (0)
#define PG8_WAIT_V(n) asm volatile("s_waitcnt vmcnt(" #n ")" ::: "memory")
#define PG8_WAIT_L(n) asm volatile("s_waitcnt lgkmcnt(" #n ")" ::: "memory")
#define PG8_BAR __builtin_amdgcn_s_barrier()
#define PG8_SCHED __builtin_amdgcn_sched_barrier(0)
    Unit cur, nxt; int ui = 0;
    if (!S.next(0, cur)) return;
    f32x4 acc[2][2][4][2];
#pragma unroll
    for (int a = 0; a < 2; ++a)
#pragma unroll
        for (int b = 0; b < 2; ++b)
#pragma unroll
            for (int m = 0; m < 4; ++m)
#pragma unroll
                for (int n = 0; n < 2; ++n) acc[a][b][m][n] = (f32x4){0.f, 0.f, 0.f, 0.f};
    bf16x8 At[4][2], B0[2][2], B1[2][2];
    const char* cA = (const char*)g.A + (size_t)cur.pm * tstep; const char* cB = (const char*)g.Bt + (size_t)cur.pn * tstep;
    PG8_STAGE(PG8_SB(0, 0), cB, voffB); PG8_STAGE(PG8_SA(0, 0), cA, voffA); PG8_STAGE(PG8_SB(0, 1), cB + hstep, voffB); PG8_STAGE(PG8_SA(0, 1), cA + hstep, voffA);
    if (wr == 1) PG8_BAR;
    PG8_WAIT_V(4); PG8_BAR;
    PG8_STAGE(PG8_SB(1, 0), cB + kstep, voffB); PG8_STAGE(PG8_SA(1, 0), cA + kstep, voffA); PG8_STAGE(PG8_SB(1, 1), cB + hstep + kstep, voffB);
    PG8_WAIT_V(6); PG8_BAR;
    for (;;) {
        const bool has_next = S.next(ui + 1, nxt);
        const char* nA = has_next ? (const char*)g.A + (size_t)nxt.pm * tstep : cA; const char* nB = has_next ? (const char*)g.Bt + (size_t)nxt.pn * tstep : cB;
        for (int t = 0; t < nt; t += 2) {
            const bool last = (t == nt - 2);
            const char* a1 = cA + (size_t)(t + 1) * kstep;
            const char* a2 = last ? nA : cA + (size_t)(t + 2) * kstep; const char* b2 = last ? nB : cB + (size_t)(t + 2) * kstep;
            const char* a3 = a2 + kstep; const char* b3 = b2 + kstep;
            PG8_LDB(B0, 0, 0); PG8_SCHED; PG8_LDA(At, 0, 0); PG8_STAGE(PG8_SA(1, 1), a1 + hstep, voffA);
            PG8_WAIT_L(8); PG8_BAR; PG8_WAIT_L(0); PG8_MMA(0, 0, At, B0); PG8_BAR; PG8_SCHED;
            PG8_LDB(B1, 0, 1); PG8_STAGE(PG8_SB(0, 0), b2, voffB);
            PG8_BAR; PG8_WAIT_L(0); PG8_MMA(0, 1, At, B1); PG8_BAR;
            PG8_LDA(At, 0, 1); PG8_STAGE(PG8_SA(0, 0), a2, voffA);
            PG8_BAR; PG8_WAIT_L(0); PG8_MMA(1, 0, At, B0); PG8_BAR; PG8_SCHED;
            PG8_STAGE(PG8_SB(0, 1), b2 + hstep, voffB);
            PG8_WAIT_V(6); PG8_BAR; PG8_MMA(1, 1, At, B1); PG8_BAR;
            PG8_LDB(B0, 1, 0); PG8_SCHED; PG8_LDA(At, 1, 0); PG8_STAGE(PG8_SA(0, 1), a2 + hstep, voffA);
            PG8_WAIT_L(8); PG8_BAR; PG8_WAIT_L(0); PG8_MMA(0, 0, At, B0); PG8_BAR; PG8_SCHED;
            PG8_LDB(B1, 1, 1); PG8_STAGE(PG8_SB(1, 0), b3, voffB);
            PG8_BAR; PG8_WAIT_L(0); PG8_MMA(0, 1, At, B1); PG8_BAR;
            PG8_LDA(At, 1, 1); PG8_STAGE(PG8_SA(1, 0), a3, voffA);
            PG8_BAR; PG8_WAIT_L(0); PG8_MMA(1, 0, At, B0); PG8_BAR; PG8_SCHED;
            PG8_STAGE(PG8_SB(1, 1), b3 + hstep, voffB);
            PG8_WAIT_V(6); PG8_BAR; PG8_MMA(1, 1, At, B1); PG8_BAR;
        }
        E(acc, cur, wr, wc, fr, fq);
        if (!has_next) break;
#pragma unroll
        for (int a = 0; a < 2; ++a)
#pragma unroll
            for (int b = 0; b < 2; ++b)
#pragma unroll
                for (int m = 0; m < 4; ++m)
#pragma unroll
                    for (int n = 0; n < 2; ++n) acc[a][b][m][n] = (f32x4){0.f, 0.f, 0.f, 0.f};
        cur = nxt; cA = nA; cB = nB; ++ui;
    }
    PG8_WAIT_V(0);
    if (wr == 0) PG8_BAR;
    PG8_BAR;
#undef PG8_SA
#undef PG8_SB
#undef PG8_STAGE
#undef PG8_LDA
#undef PG8_LDB
#undef PG8_MMA
#undef PG8_WAIT_V
#undef PG8_WAIT_L
#undef PG8_BAR
#undef PG8_SCHED
}
}

typedef f32x4 AccT[2][2][4][2];
#define EPI_LOOP_BEGIN \
    _Pragma("unroll") for (int ai = 0; ai < 2; ++ai) _Pragma("unroll") for (int m = 0; m < 4; ++m) { \
        const int row = u.pm * 256 + ai * 128 + wr * 64 + m * 16 + fr; \
        _Pragma("unroll") for (int bj = 0; bj < 2; ++bj) { const int ct = bj * 128 + wc * 32 + 8 * fq;   \
            const f32x4 v0 = acc[ai][bj][m][0], v1 = acc[ai][bj][m][1];
#define EPI_LOOP_END } }

struct EpiProj {
    unsigned char* ws;
    __device__ __forceinline__ void operator()(const AccT& acc, const pg8::Unit& u, int wr, int wc, int fr, int fq) const {
        const int pn = u.pn; bf16_t* base; int ld, c0;
        if (pn < 8)       { base = (bf16_t*)(ws + WS_CB); ld = 2048; c0 = pn * 256; }
        else if (pn < 16) { base = (bf16_t*)(ws + WS_CC); ld = 2048; c0 = (pn - 8) * 256; }
        else if (pn < 24) { base = (bf16_t*)(ws + WS_CH); ld = 2048; c0 = (pn - 16) * 256; }
        else if (pn < 32) { base = (bf16_t*)(ws + WS_Q);  ld = 2048; c0 = (pn - 24) * 256; }
        else if (pn < 34) { base = (bf16_t*)(ws + WS_K);  ld = 512;  c0 = (pn - 32) * 256; }
        else if (pn < 36) { base = (bf16_t*)(ws + WS_V);  ld = 512;  c0 = (pn - 34) * 256; }
        else if (pn < 40) { base = (bf16_t*)(ws + WS_QI); ld = 1024; c0 = (pn - 36) * 256; }
        else if (pn < 48) { base = (bf16_t*)(ws + WS_GA); ld = 2048; c0 = (pn - 40) * 256; }
        else if (pn < 56) { base = (bf16_t*)(ws + WS_GB); ld = 2048; c0 = (pn - 48) * 256; }
        else              { base = (bf16_t*)(ws + WS_KW); ld = 256;  c0 = 0; }
        EPI_LOOP_BEGIN
            u32x4 w; w.x = cvt_pk_bf16(v0[0], v0[1]); w.y = cvt_pk_bf16(v0[2], v0[3]); w.z = cvt_pk_bf16(v1[0], v1[1]); w.w = cvt_pk_bf16(v1[2], v1[3]);
            *(u32x4*)(base + (size_t)row * ld + c0 + ct) = w;
        EPI_LOOP_END
    }
};
struct EpiUp {
    bf16_t* HA; bf16_t* HG;
    __device__ __forceinline__ void operator()(const AccT& acc, const pg8::Unit& u, int wr, int wc, int fr, int fq) const {
        bf16_t* base = (u.pn < 22) ? HA : HG; const int c0 = (u.pn < 22 ? u.pn : u.pn - 22) * 256;
        EPI_LOOP_BEGIN
            u32x4 w; w.x = cvt_pk_bf16(v0[0], v0[1]); w.y = cvt_pk_bf16(v0[2], v0[3]); w.z = cvt_pk_bf16(v1[0], v1[1]); w.w = cvt_pk_bf16(v1[2], v1[3]);
            *(u32x4*)(base + (size_t)row * DFF + c0 + ct) = w;
        EPI_LOOP_END
    }
};
struct EpiGate1 {
    const bf16_t* G; float* TMP;
    __device__ __forceinline__ void operator()(const AccT& acc, const pg8::Unit& u, int wr, int wc, int fr, int fq) const {
        EPI_LOOP_BEGIN
            const size_t off = (size_t)row * DM + u.pn * 256 + ct;
            const u32x4 g = *(const u32x4*)(G + off);
            f32x4 o0, o1;
            o0[0] = sigmoidf_(bflo(g.x)) * v0[0]; o0[1] = sigmoidf_(bfhi(g.x)) * v0[1]; o0[2] = sigmoidf_(bflo(g.y)) * v0[2]; o0[3] = sigmoidf_(bfhi(g.y)) * v0[3];
            o1[0] = sigmoidf_(bflo(g.z)) * v1[0]; o1[1] = sigmoidf_(bfhi(g.z)) * v1[1]; o1[2] = sigmoidf_(bflo(g.w)) * v1[2]; o1[3] = sigmoidf_(bfhi(g.w)) * v1[3];
            *(f32x4*)(TMP + off) = o0; *(f32x4*)(TMP + off + 4) = o1;
        EPI_LOOP_END
    }
};
struct EpiGate2 {
    const bf16_t* G; const float* TMP; bf16_t* OUT;
    __device__ __forceinline__ void operator()(const AccT& acc, const pg8::Unit& u, int wr, int wc, int fr, int fq) const {
        EPI_LOOP_BEGIN
            const size_t off = (size_t)row * DM + u.pn * 256 + ct;
            const u32x4 g = *(const u32x4*)(G + off);
            const f32x4 t0 = *(const f32x4*)(TMP + off), t1 = *(const f32x4*)(TMP + off + 4);
            f32x4 o0, o1;
            o0[0] = t0[0] + sigmoidf_(bflo(g.x)) * v0[0]; o0[1] = t0[1] + sigmoidf_(bfhi(g.x)) * v0[1]; o0[2] = t0[2] + sigmoidf_(bflo(g.y)) * v0[2]; o0[3] = t0[3] + sigmoidf_(bfhi(g.y)) * v0[3];
            o1[0] = t1[0] + sigmoidf_(bflo(g.z)) * v1[0]; o1[1] = t1[1] + sigmoidf_(bfhi(g.z)) * v1[1]; o1[2] = t1[2] + sigmoidf_(bflo(g.w)) * v1[2]; o1[3] = t1[3] + sigmoidf_(bfhi(g.w)) * v1[3];
            u32x4 w; w.x = cvt_pk_bf16(o0[0], o0[1]); w.y = cvt_pk_bf16(o0[2], o0[3]); w.z = cvt_pk_bf16(o1[0], o1[1]); w.w = cvt_pk_bf16(o1[2], o1[3]);
            *(u32x4*)(OUT + off) = w;
        EPI_LOOP_END
    }
};
struct EpiRes {
    const float* X; const float* gmod  ; float* Z;
    __device__ __forceinline__ void operator()(const AccT& acc, const pg8::Unit& u, int wr, int wc, int fr, int fq) const {
        const float* gm = gmod + (u.pm >= 16 ? NMOD : 0) + u.pn * 256;
        EPI_LOOP_BEGIN
            const size_t off = (size_t)row * DM + u.pn * 256 + ct;
            const f32x4 x0 = *(const f32x4*)(X + off), x1 = *(const f32x4*)(X + off + 4);
            const f32x4 g0 = *(const f32x4*)(gm + ct), g1 = *(const f32x4*)(gm + ct + 4);
            f32x4 o0, o1;
#pragma unroll
            for (int j = 0; j < 4; ++j) { o0[j] = ALPHA * x0[j] + (1.0f + g0[j]) * v0[j]; o1[j] = ALPHA * x1[j] + (1.0f + g1[j]) * v1[j]; }
            *(f32x4*)(Z + off) = o0; *(f32x4*)(Z + off + 4) = o1;
        EPI_LOOP_END
    }
};

template <bool WIN>
__device__ __forceinline__ void transpose_item(const float* W, int K, int N, int NP, bf16_t* WT, LAS float* scr, int item, int lane) {
    const int nblk = NP / 32, kb = item / nblk, nb = item % nblk, k0 = 64 * kb, n0 = 32 * nb;
    int np = n0 + (lane & 31), sc = np; bool valid = true;
    if (WIN) {
        if (np < 10240) sc = np;
        else if (np < 12288) sc = 10320 + (np - 10240);
        else if (np < 14336) sc = 12368 + (np - 12288);
        else if (np < 14416) sc = 10240 + (np - 14336);
        else { valid = false; sc = 0; }
    }
#pragma unroll 8
    for (int i = 0; i < 32; ++i) { const int kk = 2 * i + (lane >> 5); scr[kk * 33 + (lane & 31)] = valid ? W[(size_t)(k0 + kk) * N + sc] : 0.0f; }
    asm volatile("s_waitcnt lgkmcnt(0)" ::: "memory");
    const int c = lane & 7;
#pragma unroll
    for (int j = 0; j < 4; ++j) { const int n = (lane >> 3) + 8 * j; const LAS float* s = scr + (8 * c) * 33 + n;
        u32x4 o; o.x = cvt_pk_bf16(s[0 * 33], s[1 * 33]); o.y = cvt_pk_bf16(s[2 * 33], s[3 * 33]); o.z = cvt_pk_bf16(s[4 * 33], s[5 * 33]); o.w = cvt_pk_bf16(s[6 * 33], s[7 * 33]);
        *(u32x4*)(WT + (size_t)(n0 + n) * K + k0 + 8 * c) = o; }
    asm volatile("s_waitcnt lgkmcnt(0)" ::: "memory");
}

struct Args { const float* in[18]; float* out; unsigned char* ws; };

__global__ void __launch_bounds__(NTHR, 2) fwd_megakernel(Args args) {
    extern __shared__ __attribute__((aligned(16))) unsigned char lds_raw[];
    LAS unsigned char* lds = (LAS unsigned char*)lds_raw;
    cg::grid_group grid = cg::this_grid();
    const int tid = threadIdx.x, lane = tid & 63, wave = __builtin_amdgcn_readfirstlane(tid >> 6);
    const int G = gridDim.x, bx = blockIdx.x;
    const int vcu = (G % 8 == 0) ? (bx % 8) * (G / 8) + bx / 8 : bx;
    const int gw = vcu * NWAVES + wave, NGW = G * NWAVES;
    const int gtid = vcu * NTHR + tid, NGT = G * NTHR;

    const float* x = args.in[0]; const float* cvec = args.in[1]; const float* w_cond = args.in[2]; const float* b_cond = args.in[3];
    const float* w_in = args.in[4]; const float* conv_a = args.in[5]; const float* kn_g = args.in[6]; const float* kn_b = args.in[7];
    const float* w_a = args.in[8]; const float* w_b = args.in[9]; const float* w_o = args.in[10]; const float* ln1_g = args.in[11]; const float* ln1_b = args.in[12];
    const float* w_up = args.in[13]; const float* conv_f = args.in[14]; const float* w_down = args.in[15]; const float* ln2_g = args.in[16]; const float* ln2_b = args.in[17];
    float* out = args.out; unsigned char* ws = args.ws;
    float* PART = (float*)(ws + WS_PART); float* MOD = (float*)(ws + WS_MOD);
    bf16_t* WIN_T = (bf16_t*)(ws + WS_WIN); bf16_t* WA_T = (bf16_t*)(ws + WS_WA); bf16_t* WB_T = (bf16_t*)(ws + WS_WB); bf16_t* WO_T = (bf16_t*)(ws + WS_WO);
    bf16_t* WUP_T = (bf16_t*)(ws + WS_WUP); bf16_t* WD_T = (bf16_t*)(ws + WS_WD);
    bf16_t* U = (bf16_t*)(ws + WS_U);
    bf16_t* CB = (bf16_t*)(ws + WS_CB); bf16_t* CC = (bf16_t*)(ws + WS_CC); bf16_t* CH = (bf16_t*)(ws + WS_CH); bf16_t* Q = (bf16_t*)(ws + WS_Q);
    bf16_t* GA = (bf16_t*)(ws + WS_GA); bf16_t* GB = (bf16_t*)(ws + WS_GB); bf16_t* KB = (bf16_t*)(ws + WS_K); bf16_t* VB = (bf16_t*)(ws + WS_V);
    bf16_t* VT = (bf16_t*)(ws + WS_VT); bf16_t* QI = (bf16_t*)(ws + WS_QI); bf16_t* KW = (bf16_t*)(ws + WS_KW); bf16_t* KIB = (bf16_t*)(ws + WS_KIB);
    float* WIF = (float*)(ws + WS_WIF); unsigned long long* MASK = (unsigned long long*)(ws + WS_MASK);
    float* Z = (float*)(ws + WS_Z); float* Z2 = (float*)(ws + WS_Z2); bf16_t* HA = (bf16_t*)(ws + WS_HA); bf16_t* HG = (bf16_t*)(ws + WS_HG);
    float* X1 = out; float* TMP = out;

    {
        LAS float* cact = (LAS float*)lds;
        for (int i = tid; i < 2 * DM; i += NTHR) { const float c = cvec[i]; cact[i] = c / (1.0f + __expf(-c)); }
        __syncthreads();
        for (int item = gw; item < 8 * 192; item += NGW) {
            const int kc = item / 192, cb = item % 192, col = cb * 64 + (lane & 15) * 4, kq = lane >> 4;
            f32x4 a0 = {0.f, 0.f, 0.f, 0.f}, a1 = {0.f, 0.f, 0.f, 0.f};
            const float* wp = w_cond + (size_t)(kc * 256 + kq) * NMOD + col;
#pragma unroll 8
            for (int i = 0; i < 64; ++i) { const f32x4 w = *(const f32x4*)(wp + (size_t)(4 * i) * NMOD); const int k = kc * 256 + kq + 4 * i;
                const float s0 = cact[k], s1 = cact[DM + k]; a0 += s0 * w; a1 += s1 * w; }
#pragma unroll
            for (int j = 0; j < 4; ++j) { a0[j] += __shfl_xor(a0[j], 16); a0[j] += __shfl_xor(a0[j], 32); a1[j] += __shfl_xor(a1[j], 16); a1[j] += __shfl_xor(a1[j], 32); }
            if (lane < 16) { *(f32x4*)(PART + (size_t)(kc * 2 + 0) * NMOD + col) = a0; *(f32x4*)(PART + (size_t)(kc * 2 + 1) * NMOD + col) = a1; }
        }
        LAS float* scr = (LAS float*)(lds + 16384 + wave * 8448);
        for (int it = gw; it < 32 * (NPROJ / 32); it += NGW) transpose_item<true>(w_in, DM, 14416, NPROJ, WIN_T, scr, it, lane);
    }
    grid.sync();

    {
        for (int idx = gtid; idx < 2 * NMOD; idx += NGT) { const int b = idx / NMOD, e = idx % NMOD; float s = b_cond[e];
#pragma unroll
            for (int kc = 0; kc < 8; ++kc) s += PART[(size_t)(kc * 2 + b) * NMOD + e];
            MOD[idx] = s; }
        for (int rb = vcu; rb < MT / 32; rb += G) {
            const int b = rb >> 7, col = (tid & 255) * 8, r0 = rb * 32 + (tid >> 8) * 16;
            f32x4 sh0 = *(const f32x4*)(b_cond + col), sh1 = *(const f32x4*)(b_cond + col + 4), sc0 = *(const f32x4*)(b_cond + DM + col), sc1 = *(const f32x4*)(b_cond + DM + col + 4);
#pragma unroll
            for (int kc = 0; kc < 8; ++kc) { const float* p = PART + (size_t)(kc * 2 + b) * NMOD + col;
                sh0 += *(const f32x4*)(p); sh1 += *(const f32x4*)(p + 4); sc0 += *(const f32x4*)(p + DM); sc1 += *(const f32x4*)(p + DM + 4); }
#pragma unroll 4
            for (int r = 0; r < 16; ++r) { const size_t off = (size_t)(r0 + r) * DM + col;
                const f32x4 x0 = *(const f32x4*)(x + off), x1 = *(const f32x4*)(x + off + 4);
                f32x4 u0, u1;
#pragma unroll
                for (int j = 0; j < 4; ++j) { u0[j] = x0[j] * (1.0f + sc0[j]) + sh0[j]; u1[j] = x1[j] * (1.0f + sc1[j]) + sh1[j]; }
                u32x4 w; w.x = cvt_pk_bf16(u0[0], u0[1]); w.y = cvt_pk_bf16(u0[2], u0[3]); w.z = cvt_pk_bf16(u1[0], u1[1]); w.w = cvt_pk_bf16(u1[2], u1[3]);
                *(u32x4*)(U + off) = w; }
        }
        LAS float* scr = (LAS float*)(lds + wave * 8448);
        constexpr int I_SQ = 32 * 64, I_UP = 32 * 352, I_DN = 88 * 64;
        for (int it = gw; it < 3 * I_SQ + I_UP + I_DN; it += NGW) {
            int r = it;
            if (r < I_SQ) { transpose_item<false>(w_a, DM, DM, DM, WA_T, scr, r, lane); continue; } r -= I_SQ;
            if (r < I_SQ) { transpose_item<false>(w_b, DM, DM, DM, WB_T, scr, r, lane); continue; } r -= I_SQ;
            if (r < I_SQ) { transpose_item<false>(w_o, DM, DM, DM, WO_T, scr, r, lane); continue; } r -= I_SQ;
            if (r < I_UP) { transpose_item<false>(w_up, DM, 2 * DFF, 2 * DFF, WUP_T, scr, r, lane); continue; } r -= I_UP;
            transpose_item<false>(w_down, DFF, DM, DM, WD_T, scr, r, lane);
        }
    }
    grid.sync();

    {
        pg8::Gemm g{U, WIN_T, MT, NPROJ, DM}; pg8::StaticOrder S; S.init(MT, NPROJ, G, bx);
        EpiProj E{ws};
        pg8::gemm_phase<EpiProj>(lds, g, S, E);
    }
    grid.sync();

    {
        for (int un = gtid; un < (MT / 16) * 256; un += NGT) {
            const int cg8 = un & 255, rb = un >> 8, col = cg8 * 8, m0 = rb * 16, t0 = m0 & (SEQ - 1);
            float w0[8], w1[8], w2[8], p1[8], p2[8];
#pragma unroll
            for (int j = 0; j < 8; ++j) { w0[j] = conv_a[col + j]; w1[j] = conv_a[DM + col + j]; w2[j] = conv_a[2 * DM + col + j]; p1[j] = 0.f; p2[j] = 0.f; }
            if (t0 != 0) {
                const u32x4 c2 = *(const u32x4*)(CC + (size_t)(m0 - 2) * DM + col), h2 = *(const u32x4*)(CH + (size_t)(m0 - 2) * DM + col);
                const u32x4 c1 = *(const u32x4*)(CC + (size_t)(m0 - 1) * DM + col), h1 = *(const u32x4*)(CH + (size_t)(m0 - 1) * DM + col);
#pragma unroll
                for (int j = 0; j < 4; ++j) { p2[2 * j] = bflo(c2[j]) * bflo(h2[j]); p2[2 * j + 1] = bfhi(c2[j]) * bfhi(h2[j]); p1[2 * j] = bflo(c1[j]) * bflo(h1[j]); p1[2 * j + 1] = bfhi(c1[j]) * bfhi(h1[j]); }
            }
#pragma unroll 4
            for (int r = 0; r < 16; ++r) { const size_t off = (size_t)(m0 + r) * DM + col;
                const u32x4 cc = *(const u32x4*)(CC + off), ch = *(const u32x4*)(CH + off), cb = *(const u32x4*)(CB + off);
                float p0[8], y[8];
#pragma unroll
                for (int j = 0; j < 4; ++j) { p0[2 * j] = bflo(cc[j]) * bflo(ch[j]); p0[2 * j + 1] = bfhi(cc[j]) * bfhi(ch[j]); }
#pragma unroll
                for (int j = 0; j < 8; ++j) { const float cv = w0[j] * p2[j] + w1[j] * p1[j] + w2[j] * p0[j]; const float cbv = (j & 1) ? bfhi(cb[j >> 1]) : bflo(cb[j >> 1]); y[j] = cbv * cv; p2[j] = p1[j]; p1[j] = p0[j]; }
                u32x4 w; w.x = cvt_pk_bf16(y[0], y[1]); w.y = cvt_pk_bf16(y[2], y[3]); w.z = cvt_pk_bf16(y[4], y[5]); w.w = cvt_pk_bf16(y[6], y[7]);
                *(u32x4*)(CB + off) = w; }
        }
        for (int un = vcu; un < NB * 4 * 64; un += G) {
            const int sb = un & 63, n = (un >> 6) & 3, b = un >> 8;
            LAS unsigned short* tl = (LAS unsigned short*)lds;
            __syncthreads();
#pragma unroll
            for (int j = 0; j < 2; ++j) { const int q = tid + 512 * j, row = q >> 4, ch = q & 15;
                const u32x4 v = *(const u32x4*)(VB + (size_t)(b * SEQ + sb * 64 + row) * 512 + n * 128 + ch * 8);
                LAS unsigned* d = (LAS unsigned*)(tl + row * 130 + ch * 8); d[0] = v.x; d[1] = v.y; d[2] = v.z; d[3] = v.w; }
            __syncthreads();
#pragma unroll
            for (int j = 0; j < 2; ++j) { const int q = tid + 512 * j, s8 = q & 7, d = q >> 3;
                unsigned e[8];
#pragma unroll
                for (int k = 0; k < 8; ++k) e[k] = tl[(s8 * 8 + k) * 130 + d];
                u32x4 w; w.x = e[0] | (e[1] << 16); w.y = e[2] | (e[3] << 16); w.z = e[4] | (e[5] << 16); w.w = e[6] | (e[7] << 16);
                *(u32x4*)(VT + ((size_t)((b * 4 + n) * 128 + d)) * SEQ + sb * 64 + s8 * 8) = w; }
        }
        __syncthreads();
        for (int m = gtid; m < MT; m += NGT) {
            float v[64]; float s = 0.f;
#pragma unroll
            for (int j = 0; j < 8; ++j) { const u32x4 w = *(const u32x4*)(KW + (size_t)m * 256 + j * 8);
#pragma unroll
                for (int k = 0; k < 4; ++k) { v[j * 8 + 2 * k] = bflo(w[k]); v[j * 8 + 2 * k + 1] = bfhi(w[k]); } }
#pragma unroll
            for (int j = 0; j < 64; ++j) s += v[j];
            const float mu = s * (1.0f / 64.0f); float s2 = 0.f;
#pragma unroll
            for (int j = 0; j < 64; ++j) { v[j] -= mu; s2 += v[j] * v[j]; }
            const float rstd = rsqrtf(s2 * (1.0f / 64.0f) + LN_EPS);
#pragma unroll
            for (int j = 0; j < 8; ++j) { u32x4 w;
#pragma unroll
                for (int k = 0; k < 4; ++k) { const int e = j * 8 + 2 * k; w[k] = cvt_pk_bf16(v[e] * rstd * kn_g[e] + kn_b[e], v[e + 1] * rstd * kn_g[e + 1] + kn_b[e + 1]); }
                *(u32x4*)(KIB + (size_t)m * 64 + j * 8) = w; }
#pragma unroll
            for (int j = 0; j < 2; ++j) { const u32x4 w = *(const u32x4*)(KW + (size_t)m * 256 + 64 + j * 8);
                f32x4 a, b2; a[0] = bflo(w.x); a[1] = bfhi(w.x); a[2] = bflo(w.y); a[3] = bfhi(w.y); b2[0] = bflo(w.z); b2[1] = bfhi(w.z); b2[2] = bflo(w.w); b2[3] = bfhi(w.w);
                *(f32x4*)(WIF + (size_t)m * 16 + j * 8) = a; *(f32x4*)(WIF + (size_t)m * 16 + j * 8 + 4) = b2; }
        }
    }
    grid.sync();

    for (int wq = gw; wq < 2048; wq += NGW) {
        const int c0 = wq >> 5, jt = wq & 31;
        for (int r = 0; r < 4; ++r) {
            const int b = r & 1, hh = r >> 1, tok = jt + 32 * hh, c = hh ? 63 - c0 : c0;
            const int m = b * SEQ + 64 * c + tok, nblk = c + 1;
            const bf16_t* qp = QI + (size_t)m * 1024 + (lane & 15) * 64 + (lane >> 4) * 8;
            const bf16x8 a0 = *(const bf16x8*)(qp), a1 = *(const bf16x8*)(qp + 32);
            const f32x4 w4 = *(const f32x4*)(WIF + (size_t)m * 16 + (lane >> 4) * 4);
            const bool b0 = (lane & 16) != 0, b1 = (lane & 32) != 0;
            unsigned sc[64];
            const bf16_t* kbase = KIB + (size_t)(b * SEQ + (lane & 15)) * 64 + (lane >> 4) * 8;
#pragma unroll
            for (int i = 0; i < 64; ++i) {
                unsigned key = 0u;
                if (i < nblk) {
                    float v[4];
#pragma unroll
                    for (int g = 0; g < 4; ++g) {
                        const bf16_t* kp = kbase + (size_t)(64 * i + 16 * g) * 64;
                        const bf16x8 k0 = *(const bf16x8*)(kp), k1 = *(const bf16x8*)(kp + 32);
                        f32x4 acc = {0.f, 0.f, 0.f, 0.f};
                        acc = __builtin_amdgcn_mfma_f32_16x16x32_bf16(a0, k0, acc, 0, 0, 0);
                        acc = __builtin_amdgcn_mfma_f32_16x16x32_bf16(a1, k1, acc, 0, 0, 0);
                        v[g] = w4[0] * fmaxf(acc[0], 0.f) + w4[1] * fmaxf(acc[1], 0.f) + w4[2] * fmaxf(acc[2], 0.f) + w4[3] * fmaxf(acc[3], 0.f);
                    }
                    const float s0 = b0 ? v[0] : v[1], s1 = b0 ? v[2] : v[3];
                    const float r0 = __shfl_xor(s0, 16), r1 = __shfl_xor(s1, 16);
                    const float t0 = (b0 ? v[1] : v[0]) + r0, t1 = (b0 ? v[3] : v[2]) + r1;
                    const float s2 = b1 ? t0 : t1;
                    const float r2 = __shfl_xor(s2, 32);
                    const float fin = (b1 ? t1 : t0) + r2;
                    const unsigned ub = __float_as_uint(fin);
                    key = (ub & 0x80000000u) ? ~ub : (ub | 0x80000000u);
                }
                sc[i] = key;
            }
            unsigned long long myword = 0ull;
            if (nblk <= 4) {
                if (lane < nblk) myword = ~0ull;
            } else {
                unsigned T = 0u;
                for (int bit = 31; bit >= 0; --bit) {
                    const unsigned cand = T | (1u << bit);
                    int cnt = 0;
#pragma unroll
                    for (int g8 = 0; g8 < 8; ++g8) {
                        if (g8 * 8 < nblk) {
#pragma unroll
                            for (int e = 0; e < 8; ++e) cnt += __popcll(__ballot(sc[g8 * 8 + e] >= cand));
                        }
                    }
                    if (cnt >= 256) T = cand;
                }
                int cgt = 0;
#pragma unroll
                for (int i = 0; i < 64; ++i) cgt += __popcll(__ballot(sc[i] > T));
                int need = 256 - cgt;
#pragma unroll
                for (int i = 0; i < 64; ++i) {
                    if (i < nblk) {
                        const unsigned long long gt = __ballot(sc[i] > T), eq = __ballot(sc[i] == T);
                        unsigned long long sel = 0ull;
                        if (eq != 0ull && need > 0) {
                            const int ne = __popcll(eq);
                            if (ne <= need) { sel = eq; need -= ne; }
                            else { unsigned long long tmp = eq; for (int k = 0; k < need; ++k) { const unsigned long long low = tmp & (0ull - tmp); sel |= low; tmp ^= low; } need = 0; }
                        }
                        const unsigned long long word = gt | sel;
                        if (lane == i) myword = word;
                    }
                }
            }
            MASK[(size_t)m * 64 + lane] = myword;
        }
    }
    grid.sync();

    for (int it0 = vcu; it0 < 256; it0 += G) {
        const int cc0 = it0 & 31, n = (it0 >> 5) & 3, b = it0 >> 7;
        for (int half = 0; half < 2; ++half) {
            const int c = half ? 63 - cc0 : cc0, nblk = c + 1;
            const int h = lane >> 5, r = lane & 31;
            const int hq = 4 * n + (wave >> 1), th = wave & 1;
            const int mq = b * SEQ + 64 * c + 32 * th + r;
            bf16x8 qf[8];
            { const bf16_t* qp = Q + (size_t)mq * DM + hq * 128 + 8 * h;
#pragma unroll
              for (int ks = 0; ks < 8; ++ks) qf[ks] = *(const bf16x8*)(qp + ks * 16); }
            f32x16 o[4];
#pragma unroll
            for (int dt = 0; dt < 4; ++dt)
#pragma unroll
                for (int i = 0; i < 16; ++i) o[dt][i] = 0.f;
            float mrun = -INFINITY, lrun = 0.f;
            const int kq0 = tid, kq1 = tid + 512;
            const bf16_t* ksrc0 = KB + (size_t)(b * SEQ + (kq0 >> 4)) * 512 + n * 128 + (kq0 & 15) * 8;
            const bf16_t* ksrc1 = KB + (size_t)(b * SEQ + (kq1 >> 4)) * 512 + n * 128 + (kq1 & 15) * 8;
            const int kd0 = (kq0 >> 4) * 272 + (kq0 & 15) * 16, kd1 = (kq1 >> 4) * 272 + (kq1 & 15) * 16;
            const bf16_t* vsrc0 = VT + ((size_t)((b * 4 + n) * 128 + (kq0 >> 3))) * SEQ + (kq0 & 7) * 8;
            const bf16_t* vsrc1 = VT + ((size_t)((b * 4 + n) * 128 + (kq1 >> 3))) * SEQ + (kq1 & 7) * 8;
            const int vd0 = 17408 + (kq0 >> 3) * 136 + (kq0 & 7) * 16, vd1 = 17408 + (kq1 >> 3) * 136 + (kq1 & 7) * 16;
            u32x4 pk0, pk1, pv0, pv1;
            pk0 = *(const u32x4*)(ksrc0); pk1 = *(const u32x4*)(ksrc1); pv0 = *(const u32x4*)(vsrc0); pv1 = *(const u32x4*)(vsrc1);
            {
                *(LAS u32x4*)(lds + kd0) = pk0; *(LAS u32x4*)(lds + kd1) = pk1;
                *(LAS u32x2*)(lds + vd0) = (u32x2){pv0.x, pv0.y}; *(LAS u32x2*)(lds + vd0 + 8) = (u32x2){pv0.z, pv0.w};
                *(LAS u32x2*)(lds + vd1) = (u32x2){pv1.x, pv1.y}; *(LAS u32x2*)(lds + vd1 + 8) = (u32x2){pv1.z, pv1.w};
            }
            __syncthreads();
            const unsigned long long* mrow = MASK + (size_t)mq * 64;
            for (int kt = 0; kt < nblk; ++kt) {
                const int buf = (kt & 1) * 34816;
                const bool more = (kt + 1 < nblk);
                if (more) { const size_t ko = (size_t)(kt + 1) * 64 * 512, vo = (size_t)(kt + 1) * 64;
                    pk0 = *(const u32x4*)(ksrc0 + ko); pk1 = *(const u32x4*)(ksrc1 + ko); pv0 = *(const u32x4*)(vsrc0 + vo); pv1 = *(const u32x4*)(vsrc1 + vo); }
                const unsigned long long mw = mrow[kt];
                f32x16 st[2];
#pragma unroll
                for (int sub = 0; sub < 2; ++sub) {
#pragma unroll
                    for (int i = 0; i < 16; ++i) st[sub][i] = 0.f;
                    const LAS unsigned char* kb = lds + buf + (32 * sub + r) * 272 + h * 16;
#pragma unroll
                    for (int ks = 0; ks < 8; ++ks) { const bf16x8 kf = *(const LAS bf16x8*)(kb + ks * 32);
                        st[sub] = __builtin_amdgcn_mfma_f32_32x32x16_bf16(kf, qf[ks], st[sub], 0, 0, 0); }
                }
                constexpr float CSC = 0.08838834764831845f * 1.4426950408889634f;
                float mx = -INFINITY;
#pragma unroll
                for (int sub = 0; sub < 2; ++sub) { const unsigned w = (unsigned)(sub ? (mw >> 32) : (mw & 0xffffffffull)) >> (4 * h);
#pragma unroll
                    for (int i = 0; i < 16; ++i) { const int pos = (i & 3) + 8 * (i >> 2);
                        const float sv = ((w >> pos) & 1u) ? st[sub][i] * CSC : -INFINITY; st[sub][i] = sv; mx = fmaxf(mx, sv); } }
                mx = fmaxf(mx, __shfl_xor(mx, 32));
                const float mnew = fmaxf(mrun, mx), msafe = (mnew == -INFINITY) ? 0.f : mnew;
                const float alpha = __builtin_amdgcn_exp2f(mrun - msafe);
                float ls = 0.f;
#pragma unroll
                for (int sub = 0; sub < 2; ++sub)
#pragma unroll
                    for (int i = 0; i < 16; ++i) { const float p = __builtin_amdgcn_exp2f(st[sub][i] - msafe); st[sub][i] = p; ls += p; }
                lrun = lrun * alpha + ls; mrun = mnew;
#pragma unroll
                for (int dt = 0; dt < 4; ++dt)
#pragma unroll
                    for (int i = 0; i < 16; ++i) o[dt][i] *= alpha;
#pragma unroll
                for (int sub = 0; sub < 2; ++sub)
#pragma unroll
                    for (int s = 0; s < 2; ++s) {
                        u32x4 pw; pw.x = cvt_pk_bf16(st[sub][8 * s + 0], st[sub][8 * s + 1]); pw.y = cvt_pk_bf16(st[sub][8 * s + 2], st[sub][8 * s + 3]);
                        pw.z = cvt_pk_bf16(st[sub][8 * s + 4], st[sub][8 * s + 5]); pw.w = cvt_pk_bf16(st[sub][8 * s + 6], st[sub][8 * s + 7]);
                        const bf16x8 pf = __builtin_bit_cast(bf16x8, pw);
#pragma unroll
                        for (int dt = 0; dt < 4; ++dt) {
                            const LAS unsigned char* vp = lds + buf + 17408 + (32 * dt + r) * 136 + (32 * sub + 16 * s + 4 * h) * 2;
                            const u32x2 lo = *(const LAS u32x2*)(vp), hi = *(const LAS u32x2*)(vp + 16);
                            const u32x4 vw = {lo.x, lo.y, hi.x, hi.y};
                            o[dt] = __builtin_amdgcn_mfma_f32_32x32x16_bf16(__builtin_bit_cast(bf16x8, vw), pf, o[dt], 0, 0, 0);
                        }
                    }
                if (more) { const int nb2 = ((kt + 1) & 1) * 34816;
                    *(LAS u32x4*)(lds + nb2 + kd0) = pk0; *(LAS u32x4*)(lds + nb2 + kd1) = pk1;
                    *(LAS u32x2*)(lds + nb2 + vd0) = (u32x2){pv0.x, pv0.y}; *(LAS u32x2*)(lds + nb2 + vd0 + 8) = (u32x2){pv0.z, pv0.w};
                    *(LAS u32x2*)(lds + nb2 + vd1) = (u32x2){pv1.x, pv1.y}; *(LAS u32x2*)(lds + nb2 + vd1 + 8) = (u32x2){pv1.z, pv1.w}; }
                __syncthreads();
            }
            const float ltot = lrun + __shfl_xor(lrun, 32);
            const float inv = 1.0f / ltot;
            bf16_t* op = Q + (size_t)mq * DM + hq * 128 + 4 * h;
#pragma unroll
            for (int dt = 0; dt < 4; ++dt)
#pragma unroll
                for (int g4 = 0; g4 < 4; ++g4) {
                    u32x2 w; w.x = cvt_pk_bf16(o[dt][4 * g4 + 0] * inv, o[dt][4 * g4 + 1] * inv); w.y = cvt_pk_bf16(o[dt][4 * g4 + 2] * inv, o[dt][4 * g4 + 3] * inv);
                    *(u32x2*)(op + 32 * dt + 8 * g4) = w; }
        }
    }
    grid.sync();

    {
        pg8::StaticOrder S; S.init(MT, DM, G, bx);
        { pg8::Gemm g{CB, WA_T, MT, DM, DM}; EpiGate1 E{GA, TMP}; pg8::gemm_phase<EpiGate1>(lds, g, S, E); }
        { pg8::Gemm g{Q, WB_T, MT, DM, DM}; EpiGate2 E{GB, TMP, U}; pg8::gemm_phase<EpiGate2>(lds, g, S, E); }
    }
    grid.sync();

    {
        pg8::Gemm g{U, WO_T, MT, DM, DM}; pg8::StaticOrder S; S.init(MT, DM, G, bx);
        EpiRes E{x, MOD + 2 * DM, Z};
        pg8::gemm_phase<EpiRes>(lds, g, S, E);
    }
    grid.sync();

    for (int m = gw; m < MT; m += NGW) {
        const int b = m >> 12;
        const float* zr = Z + (size_t)m * DM;
        f32x4 v[8]; float s = 0.f;
#pragma unroll
        for (int j = 0; j < 8; ++j) { v[j] = *(const f32x4*)(zr + j * 256 + lane * 4); s += (v[j][0] + v[j][1]) + (v[j][2] + v[j][3]); }
        const float mu = wave_sum(s) * (1.0f / DM); float s2 = 0.f;
#pragma unroll
        for (int j = 0; j < 8; ++j) { v[j] = v[j] - mu; s2 += (v[j][0] * v[j][0] + v[j][1] * v[j][1]) + (v[j][2] * v[j][2] + v[j][3] * v[j][3]); }
        const float rstd = rsqrtf(wave_sum(s2) * (1.0f / DM) + LN_EPS);
        const float* shf = MOD + (size_t)b * NMOD + 3 * DM; const float* scf = MOD + (size_t)b * NMOD + 4 * DM;
#pragma unroll
        for (int j = 0; j < 8; ++j) { const int col = j * 256 + lane * 4;
            const f32x4 gg = *(const f32x4*)(ln1_g + col), bb = *(const f32x4*)(ln1_b + col), sc4 = *(const f32x4*)(scf + col), sh4 = *(const f32x4*)(shf + col);
            f32x4 y, uu;
#pragma unroll
            for (int k = 0; k < 4; ++k) { y[k] = v[j][k] * rstd * gg[k] + bb[k]; uu[k] = y[k] * (1.0f + sc4[k]) + sh4[k]; }
            *(f32x4*)(X1 + (size_t)m * DM + col) = y;
            u32x2 w; w.x = cvt_pk_bf16(uu[0], uu[1]); w.y = cvt_pk_bf16(uu[2], uu[3]);
            *(u32x2*)(U + (size_t)m * DM + col) = w; }
    }
    grid.sync();

    {
        pg8::Gemm g{U, WUP_T, MT, 2 * DFF, DM}; pg8::StaticOrder S; S.init(MT, 2 * DFF, G, bx);
        EpiUp E{HA, HG};
        pg8::gemm_phase<EpiUp>(lds, g, S, E);
    }
    grid.sync();

    for (int un = gtid; un < (MT / 16) * (DFF / 8); un += NGT) {
        const int cg8 = un % (DFF / 8), rb = un / (DFF / 8), col = cg8 * 8, m0 = rb * 16, t0 = m0 & (SEQ - 1);
        float w0[8], w1[8], w2[8], p1[8], p2[8];
#pragma unroll
        for (int j = 0; j < 8; ++j) { w0[j] = conv_f[col + j]; w1[j] = conv_f[DFF + col + j]; w2[j] = conv_f[2 * DFF + col + j]; p1[j] = 0.f; p2[j] = 0.f; }
        if (t0 != 0) {
            const u32x4 a2 = *(const u32x4*)(HA + (size_t)(m0 - 2) * DFF + col), a1 = *(const u32x4*)(HA + (size_t)(m0 - 1) * DFF + col);
#pragma unroll
            for (int j = 0; j < 4; ++j) { p2[2 * j] = bflo(a2[j]); p2[2 * j + 1] = bfhi(a2[j]); p1[2 * j] = bflo(a1[j]); p1[2 * j + 1] = bfhi(a1[j]); }
        }
#pragma unroll 4
        for (int r = 0; r < 16; ++r) { const size_t off = (size_t)(m0 + r) * DFF + col;
            const u32x4 a = *(const u32x4*)(HA + off), gt = *(const u32x4*)(HG + off);
            float p0[8], y[8];
#pragma unroll
            for (int j = 0; j < 4; ++j) { p0[2 * j] = bflo(a[j]); p0[2 * j + 1] = bfhi(a[j]); }
#pragma unroll
            for (int j = 0; j < 8; ++j) { const float cv = w0[j] * p2[j] + w1[j] * p1[j] + w2[j] * p0[j];
                const float inner = 0.7978845608028654f * (cv + 0.044715f * cv * cv * cv);
                const float ge = cv * __builtin_amdgcn_rcpf(1.0f + __expf(-2.0f * inner));
                const float gv = (j & 1) ? bfhi(gt[j >> 1]) : bflo(gt[j >> 1]); y[j] = ge * gv; p2[j] = p1[j]; p1[j] = p0[j]; }
            u32x4 w; w.x = cvt_pk_bf16(y[0], y[1]); w.y = cvt_pk_bf16(y[2], y[3]); w.z = cvt_pk_bf16(y[4], y[5]); w.w = cvt_pk_bf16(y[6], y[7]);
            *(u32x4*)(HG + off) = w; }
    }
    grid.sync();

    {
        pg8::Gemm g{HG, WD_T, MT, DM, DFF}; pg8::StaticOrder S; S.init(MT, DM, G, bx);
        EpiRes E{X1, MOD + 5 * DM, Z2};
        pg8::gemm_phase<EpiRes>(lds, g, S, E);
    }
    grid.sync();

    for (int m = gw; m < MT; m += NGW) {
        const float* zr = Z2 + (size_t)m * DM;
        f32x4 v[8]; float s = 0.f;
#pragma unroll
        for (int j = 0; j < 8; ++j) { v[j] = *(const f32x4*)(zr + j * 256 + lane * 4); s += (v[j][0] + v[j][1]) + (v[j][2] + v[j][3]); }
        const float mu = wave_sum(s) * (1.0f / DM); float s2 = 0.f;
#pragma unroll
        for (int j = 0; j < 8; ++j) { v[j] = v[j] - mu; s2 += (v[j][0] * v[j][0] + v[j][1] * v[j][1]) + (v[j][2] * v[j][2] + v[j][3] * v[j][3]); }
        const float rstd = rsqrtf(wave_sum(s2) * (1.0f / DM) + LN_EPS);
#pragma unroll
        for (int j = 0; j < 8; ++j) { const int col = j * 256 + lane * 4;
            const f32x4 gg = *(const f32x4*)(ln2_g + col), bb = *(const f32x4*)(ln2_b + col);
            f32x4 y;
#pragma unroll
            for (int k = 0; k < 4; ++k) y[k] = v[j][k] * rstd * gg[k] + bb[k];
            *(f32x4*)(out + (size_t)m * DM + col) = y; }
    }
}

extern "C" void kernel_launch(void* const* d_in, const int* in_sizes, int n_in, void* d_out, int out_size, void* d_ws, size_t ws_size, hipStream_t stream) {
    static int grid_blocks = 0;
    if (grid_blocks == 0) {
        if (n_in != 18 || ws_size < WS_END) { fprintf(stderr, "kernel_launch: unexpected n_in %d or ws_size %zu (< %zu)\n", n_in, ws_size, (size_t)WS_END); grid_blocks = -1; return; }
        int dev = 0, cus = 0, per_cu = 0;
        hipGetDevice(&dev);
        hipDeviceGetAttribute(&cus, hipDeviceAttributeMultiprocessorCount, dev);
        if (hipFuncSetAttribute((const void*)fwd_megakernel, hipFuncAttributeMaxDynamicSharedMemorySize, LDS_BYTES) != hipSuccess) { fprintf(stderr, "kernel_launch: hipFuncSetAttribute failed\n"); grid_blocks = -1; return; }
        hipOccupancyMaxActiveBlocksPerMultiprocessor(&per_cu, (const void*)fwd_megakernel, NTHR, LDS_BYTES);
        if (per_cu < 1) { fprintf(stderr, "kernel_launch: occupancy query says %d\n", per_cu); per_cu = 1; }
        (void)hipGetLastError();
        grid_blocks = cus * per_cu;
    }
    if (grid_blocks < 0) return;
    Args a{};
    for (int i = 0; i < 18; ++i) a.in[i] = (const float*)d_in[i];
    a.out = (float*)d_out; a.ws = (unsigned char*)d_ws;
    void* kargs[] = {&a};
    hipError_t e = hipLaunchCooperativeKernel((const void*)fwd_megakernel, dim3(grid_blocks), dim3(NTHR), kargs, LDS_BYTES, stream);
    if (e != hipSuccess) fprintf(stderr, "cooperative launch failed: %s (grid %d)\n", hipGetErrorString(e), grid_blocks);
}
```

```cpp
#include <hip/hip_runtime.h>
#include <hip/hip_cooperative_groups.h>
#include <cstdio>
namespace cg = cooperative_groups;

#define LAS __attribute__((address_space(3)))
typedef unsigned short bf16_t;
typedef short bf16x8 __attribute__((ext_vector_type(8)));
typedef float f32x4 __attribute__((ext_vector_type(4)));
typedef float f32x16 __attribute__((ext_vector_type(16)));
typedef unsigned u32x4 __attribute__((ext_vector_type(4)));
typedef unsigned u32x2 __attribute__((ext_vector_type(2)));

constexpr int NB = 2, SEQ = 4096, DM = 2048, MT = NB * SEQ;
constexpr int NPROJ = 14592;
constexpr int DFF = 5632, NMOD = 12288;
constexpr float ALPHA = 1.189207115002721f;
constexpr float LN_EPS = 1e-5f;
constexpr int NWAVES = 8, NTHR = 512;
constexpr int LDS_BYTES = 147456;

constexpr size_t al256(size_t x) { return (x + 255) & ~(size_t)255; }
constexpr size_t WS_PART = 1u << 20;
constexpr size_t WS_MOD  = WS_PART + al256((size_t)8 * 2 * NMOD * 4);
constexpr size_t WS_WIN  = WS_MOD + al256((size_t)2 * NMOD * 4);
constexpr size_t WS_WA   = WS_WIN + (size_t)NPROJ * DM * 2;
constexpr size_t WS_WB   = WS_WA + (size_t)DM * DM * 2;
constexpr size_t WS_WO   = WS_WB + (size_t)DM * DM * 2;
constexpr size_t WS_WUP  = WS_WO + (size_t)DM * DM * 2;
constexpr size_t WS_WD   = WS_WUP + (size_t)2 * DFF * DM * 2;
constexpr size_t WS_U    = WS_WD + (size_t)DM * DFF * 2;
constexpr size_t ACT     = (size_t)MT * DM * 2;
constexpr size_t WS_CB   = WS_U + ACT;
constexpr size_t WS_CC   = WS_CB + ACT;
constexpr size_t WS_CH   = WS_CC + ACT;
constexpr size_t WS_Q    = WS_CH + ACT;
constexpr size_t WS_GA   = WS_Q + ACT;
constexpr size_t WS_GB   = WS_GA + ACT;
constexpr size_t WS_K    = WS_GB + ACT;
constexpr size_t WS_V    = WS_K + (size_t)MT * 512 * 2;
constexpr size_t WS_VT   = WS_V + (size_t)MT * 512 * 2;
constexpr size_t WS_QI   = WS_VT + (size_t)MT * 512 * 2;
constexpr size_t WS_KW   = WS_QI + (size_t)MT * 1024 * 2;
constexpr size_t WS_KIB  = WS_KW + (size_t)MT * 256 * 2;
constexpr size_t WS_WIF  = WS_KIB + (size_t)MT * 64 * 2;
constexpr size_t WS_MASK = WS_WIF + (size_t)MT * 16 * 4;
constexpr size_t WS_END  = WS_MASK + (size_t)MT * 64 * 8;
constexpr size_t WS_Z    = WS_CC;
constexpr size_t WS_HA   = WS_CB;
constexpr size_t WS_HG   = WS_CB + (size_t)MT * DFF * 2;
constexpr size_t WS_Z2   = WS_CB;
static_assert(WS_HG + (size_t)MT * DFF * 2 <= WS_K, "up-proj overlay fits in the proj region");

__device__ __forceinline__ unsigned cvt_pk_bf16(float lo, float hi) { unsigned r; asm volatile("v_cvt_pk_bf16_f32 %0, %1, %2" : "=v"(r) : "v"(lo), "v"(hi)); return r; }
__device__ __forceinline__ float bflo(unsigned w) { return __uint_as_float(w << 16); }
__device__ __forceinline__ float bfhi(unsigned w) { return __uint_as_float(w & 0xffff0000u); }
__device__ __forceinline__ float sigmoidf_(float g) { return __builtin_amdgcn_rcpf(1.0f + __expf(-g)); }
__device__ __forceinline__ float wave_sum(float v) {
#pragma unroll
    for (int o = 1; o < 64; o <<= 1) v += __shfl_xor(v, o);
    return v;
}

namespace pg8 {
constexpr int BM = 256, BK = 64, HALF = 128, HTB = HALF * BK * 2, STAGE_BYTES = 8 * HTB, NXCD = 8, WGM = 8;
__host__ __device__ __forceinline__ int lds_byte(int r, int c) { const int st = (r >> 4) * 2 + (c >> 5), rr = r & 15, cc = c & 31, ob = rr * 64 + cc * 2; return st * 1024 + (ob ^ (((ob >> 9) & 1) << 5)); }
__host__ __device__ __forceinline__ void stage_rc(int b, int& R, int& C) { const int st = b / 1024, sb = b % 1024, swz = sb ^ (((sb >> 9) & 1) << 5); R = (st >> 1) * 16 + swz / 64; C = (st & 1) * 32 + (swz % 64) / 2; }
__host__ __device__ __forceinline__ int perm32(int rho) { const int n = rho >> 4, i = rho & 15; return 8 * (i >> 2) + 4 * n + (i & 3); }
struct Unit { int pm, pn; };
struct Gemm { const bf16_t* A; const bf16_t* Bt; int M, N, K; };
struct StaticOrder {
    int nM, nN, nwg, G, c;
    __host__ __device__ void init(int M, int N, int G_, int c_) { nM = M / BM; nN = N / BM; nwg = nM * nN; G = G_; c = c_; }
    __host__ __device__ bool next(int i, Unit& u) const {
        const long L = (long)i * G + c; if (L >= nwg) return false;
        int wgid = (int)L; { const int q = nwg / NXCD, r = nwg % NXCD, xcd = wgid % NXCD, off = wgid / NXCD; wgid = (xcd < r ? xcd * (q + 1) : r * (q + 1) + (xcd - r) * q) + off; }
        const int nig = WGM * nN, gid = wgid / nig, fm = gid * WGM, gsz = (nM - fm) < WGM ? (nM - fm) : WGM;
        u.pm = fm + ((wgid % nig) % gsz); u.pn = (wgid % nig) / gsz; return true;
    }
};
template <class Epi>
__device__ __forceinline__ void gemm_phase(LAS unsigned char* lds, const Gemm g, const StaticOrder& S, const Epi& E) {
    const int tid = threadIdx.x, wid = __builtin_amdgcn_readfirstlane(tid >> 6), lane = tid & 63, wr = wid >> 2, wc = wid & 3, fr = lane & 15, fq = lane >> 4;
    const int K = g.K, nt = K / BK;
    unsigned voffA[2], voffB[2];
#pragma unroll
    for (int i = 0; i < 2; ++i) { int R, C; stage_rc(tid * 16 + i * 8192, R, C); const int Rb = (R & ~31) + perm32(R & 31);
        voffA[i] = (unsigned)(R * K + C) * 2u; voffB[i] = (unsigned)(Rb * K + C) * 2u; }
    const size_t kstep = (size_t)(BK * 2);
    const size_t hstep = (size_t)HALF * K * 2;
    const size_t tstep = 2 * hstep;
    const unsigned ldsw = (unsigned)wid * 1024u;
    const int aoff = lds_byte(wr * 64 + fr, fq * 8), boff = lds_byte(wc * 32 + fr, fq * 8);
#define PG8_SA(b, h) (((b) * 2 + (h)) * HTB)
#define PG8_SB(b, h) ((4 + (b) * 2 + (h)) * HTB)
#define PG8_STAGE(bufoff, gbase, voff) do { _Pragma("unroll") for (int _i = 0; _i < 2; ++_i) \
        __builtin_amdgcn_global_load_lds((const unsigned*)((const char*)(gbase) + (voff)[_i]), (LAS unsigned*)(lds + (bufoff) + ldsw + _i * 8192), 16, 0, 0); } while (0)
#define PG8_LDA(dst, b, h) do { _Pragma("unroll") for (int m = 0; m < 4; ++m) _Pragma("unroll") for (int k = 0; k < 2; ++k) dst[m][k] = *(const LAS bf16x8*)(lds + PG8_SA(b, h) + aoff + m * 2048 + k * 1024); } while (0)
#define PG8_LDB(dst, b, h) do { _Pragma("unroll") for (int n = 0; n < 2; ++n) _Pragma("unroll") for (int k = 0; k < 2; ++k) dst[n][k] = *(const LAS bf16x8*)(lds + PG8_SB(b, h) + boff + n * 2048 + k * 1024); } while (0)
#define PG8_MMA(ai, bj, At, Bt) do { __builtin_amdgcn_s_setprio(1); _Pragma("unroll") for (int m = 0; m < 4; ++m) _Pragma("unroll") for (int n = 0; n < 2; ++n) _Pragma("unroll") for (int k = 0; k < 2; ++k) \
        acc[ai][bj][m][n] = __builtin_amdgcn_mfma_f32_16x16x32_bf16(Bt[n][k], At[m][k], acc[ai][bj][m][n], 0, 0, 0); __builtin_amdgcn_s_setprio(0); } while (0)
#define PG8_WAIT_V(n) asm volatile("s_waitcnt vmcnt(" #n ")" ::: "memory")
#define PG8_WAIT_L(n) asm volatile("s_waitcnt lgkmcnt(" #n ")" ::: "memory")
#define PG8_BAR __builtin_amdgcn_s_barrier()
#define PG8_SCHED __builtin_amdgcn_sched_barrier(0)
    Unit cur, nxt; int ui = 0;
    if (!S.next(0, cur)) return;
    f32x4 acc[2][2][4][2];
#pragma unroll
    for (int a = 0; a < 2; ++a)
#pragma unroll
        for (int b = 0; b < 2; ++b)
#pragma unroll
            for (int m = 0; m < 4; ++m)
#pragma unroll
                for (int n = 0; n < 2; ++n) acc[a][b][m][n] = (f32x4){0.f, 0.f, 0.f, 0.f};
    bf16x8 At[4][2], B0[2][2], B1[2][2];
    const char* cA = (const char*)g.A + (size_t)cur.pm * tstep; const char* cB = (const char*)g.Bt + (size_t)cur.pn * tstep;
    PG8_STAGE(PG8_SB(0, 0), cB, voffB); PG8_STAGE(PG8_SA(0, 0), cA, voffA); PG8_STAGE(PG8_SB(0, 1), cB + hstep, voffB); PG8_STAGE(PG8_SA(0, 1), cA + hstep, voffA);
    if (wr == 1) PG8_BAR;
    PG8_WAIT_V(4); PG8_BAR;
    PG8_STAGE(PG8_SB(1, 0), cB + kstep, voffB); PG8_STAGE(PG8_SA(1, 0), cA + kstep, voffA); PG8_STAGE(PG8_SB(1, 1), cB + hstep + kstep, voffB);
    PG8_WAIT_V(6); PG8_BAR;
    for (;;) {
        const bool has_next = S.next(ui + 1, nxt);
        const char* nA = has_next ? (const char*)g.A + (size_t)nxt.pm * tstep : cA; const char* nB = has_next ? (const char*)g.Bt + (size_t)nxt.pn * tstep : cB;
        for (int t = 0; t < nt; t += 2) {
            const bool last = (t == nt - 2);
            const char* a1 = cA + (size_t)(t + 1) * kstep;
            const char* a2 = last ? nA : cA + (size_t)(t + 2) * kstep; const char* b2 = last ? nB : cB + (size_t)(t + 2) * kstep;
            const char* a3 = a2 + kstep; const char* b3 = b2 + kstep;
            PG8_LDB(B0, 0, 0); PG8_SCHED; PG8_LDA(At, 0, 0); PG8_STAGE(PG8_SA(1, 1), a1 + hstep, voffA);
            PG8_WAIT_L(8); PG8_BAR; PG8_WAIT_L(0); PG8_MMA(0, 0, At, B0); PG8_BAR; PG8_SCHED;
            PG8_LDB(B1, 0, 1); PG8_STAGE(PG8_SB(0, 0), b2, voffB);
            PG8_BAR; PG8_WAIT_L(0); PG8_MMA(0, 1, At, B1); PG8_BAR;
            PG8_LDA(At, 0, 1); PG8_STAGE(PG8_SA(0, 0), a2, voffA);
            PG8_BAR; PG8_WAIT_L(0); PG8_MMA(1, 0, At, B0); PG8_BAR; PG8_SCHED;
            PG8_STAGE(PG8_SB(0, 1), b2 + hstep, voffB);
            PG8_WAIT_V(6); PG8_BAR; PG8_MMA(1, 1, At, B1); PG8_BAR;
            PG8_LDB(B0, 1, 0); PG8_SCHED; PG8_LDA(At, 1, 0); PG8_STAGE(PG8_SA(0, 1), a2 + hstep, voffA);
            PG8_WAIT_L(8); PG8_BAR; PG8_WAIT_L(0); PG8_MMA(0, 0, At, B0); PG8_BAR; PG8_SCHED;
            PG8_LDB(B1, 1, 1); PG8_STAGE(PG8_SB(1, 0), b3, voffB);
            PG8_BAR; PG8_WAIT_L(0); PG8_MMA(0, 1, At, B1); PG8_BAR;
            PG8_LDA(At, 1, 1); PG8_STAGE(PG8_SA(1, 0), a3, voffA);
            PG8_BAR; PG8_WAIT_L(0); PG8_MMA(1, 0, At, B0); PG8_BAR; PG8_SCHED;
            PG8_STAGE(PG8_SB(1, 1), b3 + hstep, voffB);
            PG8_WAIT_V(6); PG8_BAR; PG8_MMA(1, 1, At, B1); PG8_BAR;
        }
        E(acc, cur, wr, wc, fr, fq);
        if (!has_next) break;
#pragma unroll
        for (int a = 0; a < 2; ++a)
#pragma unroll
            for (int b = 0; b < 2; ++b)
#pragma unroll
                for (int m = 0; m < 4; ++m)
#pragma unroll
                    for (int n = 0; n < 2; ++n) acc[a][b][m][n] = (f32x4){0.f, 0.f, 0.f, 0.f};
        cur = nxt; cA = nA; cB = nB; ++ui;
    }
    PG8_WAIT_V(0);
    if (wr == 0) PG8_BAR;
    PG8_BAR;
#undef PG8_SA
#undef PG8_SB
#undef PG8_STAGE
#undef PG8_LDA
#undef PG8_LDB
#undef PG8_MMA
#undef PG8_WAIT_V
#undef PG8_WAIT_L
#undef PG8_BAR
#undef PG8_SCHED
}
}

typedef f32x4 AccT[2][2][4][2];
#define EPI_LOOP_BEGIN \
    _Pragma("unroll") for (int ai = 0; ai < 2; ++ai) _Pragma("unroll") for (int m = 0; m < 4; ++m) { \
        const int row = u.pm * 256 + ai * 128 + wr * 64 + m * 16 + fr; \
        _Pragma("unroll") for (int bj = 0; bj < 2; ++bj) { const int ct = bj * 128 + wc * 32 + 8 * fq;   \
            const f32x4 v0 = acc[ai][bj][m][0], v1 = acc[ai][bj][m][1];
#define EPI_LOOP_END } }

struct EpiProj {
    unsigned char* ws;
    __device__ __forceinline__ void operator()(const AccT& acc, const pg8::Unit& u, int wr, int wc, int fr, int fq) const {
        const int pn = u.pn; bf16_t* base; int ld, c0;
        if (pn < 8)       { base = (bf16_t*)(ws + WS_CB); ld = 2048; c0 = pn * 256; }
        else if (pn < 16) { base = (bf16_t*)(ws + WS_CC); ld = 2048; c0 = (pn - 8) * 256; }
        else if (pn < 24) { base = (bf16_t*)(ws + WS_CH); ld = 2048; c0 = (pn - 16) * 256; }
        else if (pn < 32) { base = (bf16_t*)(ws + WS_Q);  ld = 2048; c0 = (pn - 24) * 256; }
        else if (pn < 34) { base = (bf16_t*)(ws + WS_K);  ld = 512;  c0 = (pn - 32) * 256; }
        else if (pn < 36) { base = (bf16_t*)(ws + WS_V);  ld = 512;  c0 = (pn - 34) * 256; }
        else if (pn < 40) { base = (bf16_t*)(ws + WS_QI); ld = 1024; c0 = (pn - 36) * 256; }
        else if (pn < 48) { base = (bf16_t*)(ws + WS_GA); ld = 2048; c0 = (pn - 40) * 256; }
        else if (pn < 56) { base = (bf16_t*)(ws + WS_GB); ld = 2048; c0 = (pn - 48) * 256; }
        else              { base = (bf16_t*)(ws + WS_KW); ld = 256;  c0 = 0; }
        EPI_LOOP_BEGIN
            u32x4 w; w.x = cvt_pk_bf16(v0[0], v0[1]); w.y = cvt_pk_bf16(v0[2], v0[3]); w.z = cvt_pk_bf16(v1[0], v1[1]); w.w = cvt_pk_bf16(v1[2], v1[3]);
            *(u32x4*)(base + (size_t)row * ld + c0 + ct) = w;
        EPI_LOOP_END
    }
};
struct EpiUp {
    bf16_t* HA; bf16_t* HG;
    __device__ __forceinline__ void operator()(const AccT& acc, const pg8::Unit& u, int wr, int wc, int fr, int fq) const {
        bf16_t* base = (u.pn < 22) ? HA : HG; const int c0 = (u.pn < 22 ? u.pn : u.pn - 22) * 256;
        EPI_LOOP_BEGIN
            u32x4 w; w.x = cvt_pk_bf16(v0[0], v0[1]); w.y = cvt_pk_bf16(v0[2], v0[3]); w.z = cvt_pk_bf16(v1[0], v1[1]); w.w = cvt_pk_bf16(v1[2], v1[3]);
            *(u32x4*)(base + (size_t)row * DFF + c0 + ct) = w;
        EPI_LOOP_END
    }
};
struct EpiGate1 {
    const bf16_t* G; float* TMP;
    __device__ __forceinline__ void operator()(const AccT& acc, const pg8::Unit& u, int wr, int wc, int fr, int fq) const {
        EPI_LOOP_BEGIN
            const size_t off = (size_t)row * DM + u.pn * 256 + ct;
            const u32x4 g = *(const u32x4*)(G + off);
            f32x4 o0, o1;
            o0[0] = sigmoidf_(bflo(g.x)) * v0[0]; o0[1] = sigmoidf_(bfhi(g.x)) * v0[1]; o0[2] = sigmoidf_(bflo(g.y)) * v0[2]; o0[3] = sigmoidf_(bfhi(g.y)) * v0[3];
            o1[0] = sigmoidf_(bflo(g.z)) * v1[0]; o1[1] = sigmoidf_(bfhi(g.z)) * v1[1]; o1[2] = sigmoidf_(bflo(g.w)) * v1[2]; o1[3] = sigmoidf_(bfhi(g.w)) * v1[3];
            *(f32x4*)(TMP + off) = o0; *(f32x4*)(TMP + off + 4) = o1;
        EPI_LOOP_END
    }
};
struct EpiGate2 {
    const bf16_t* G; const float* TMP; bf16_t* OUT;
    __device__ __forceinline__ void operator()(const AccT& acc, const pg8::Unit& u, int wr, int wc, int fr, int fq) const {
        EPI_LOOP_BEGIN
            const size_t off = (size_t)row * DM + u.pn * 256 + ct;
            const u32x4 g = *(const u32x4*)(G + off);
            const f32x4 t0 = *(const f32x4*)(TMP + off), t1 = *(const f32x4*)(TMP + off + 4);
            f32x4 o0, o1;
            o0[0] = t0[0] + sigmoidf_(bflo(g.x)) * v0[0]; o0[1] = t0[1] + sigmoidf_(bfhi(g.x)) * v0[1]; o0[2] = t0[2] + sigmoidf_(bflo(g.y)) * v0[2]; o0[3] = t0[3] + sigmoidf_(bfhi(g.y)) * v0[3];
            o1[0] = t1[0] + sigmoidf_(bflo(g.z)) * v1[0]; o1[1] = t1[1] + sigmoidf_(bfhi(g.z)) * v1[1]; o1[2] = t1[2] + sigmoidf_(bflo(g.w)) * v1[2]; o1[3] = t1[3] + sigmoidf_(bfhi(g.w)) * v1[3];
            u32x4 w; w.x = cvt_pk_bf16(o0[0], o0[1]); w.y = cvt_pk_bf16(o0[2], o0[3]); w.z = cvt_pk_bf16(o1[0], o1[1]); w.w = cvt_pk_bf16(o1[2], o1[3]);
            *(u32x4*)(OUT + off) = w;
        EPI_LOOP_END
    }
};
struct EpiRes {
    const float* X; const float* gmod  ; float* Z;
    __device__ __forceinline__ void operator()(const AccT& acc, const pg8::Unit& u, int wr, int wc, int fr, int fq) const {
        const float* gm = gmod + (u.pm >= 16 ? NMOD : 0) + u.pn * 256;
        EPI_LOOP_BEGIN
            const size_t off = (size_t)row * DM + u.pn * 256 + ct;
            const f32x4 x0 = *(const f32x4*)(X + off), x1 = *(const f32x4*)(X + off + 4);
            const f32x4 g0 = *(const f32x4*)(gm + ct), g1 = *(const f32x4*)(gm + ct + 4);
            f32x4 o0, o1;
#pragma unroll
            for (int j = 0; j < 4; ++j) { o0[j] = ALPHA * x0[j] + (1.0f + g0[j]) * v0[j]; o1[j] = ALPHA * x1[j] + (1.0f + g1[j]) * v1[j]; }
            *(f32x4*)(Z + off) = o0; *(f32x4*)(Z + off + 4) = o1;
        EPI_LOOP_END
    }
};

template <bool WIN>
__device__ __forceinline__ void transpose_item(const float* W, int K, int N, int NP, bf16_t* WT, LAS float* scr, int item, int lane) {
    const int nblk = NP / 32, kb = item / nblk, nb = item % nblk, k0 = 64 * kb, n0 = 32 * nb;
    int np = n0 + (lane & 31), sc = np; bool valid = true;
    if (WIN) {
        if (np < 10240) sc = np;
        else if (np < 12288) sc = 10320 + (np - 10240);
        else if (np < 14336) sc = 12368 + (np - 12288);
        else if (np < 14416) sc = 10240 + (np - 14336);
        else { valid = false; sc = 0; }
    }
#pragma unroll 8
    for (int i = 0; i < 32; ++i) { const int kk = 2 * i + (lane >> 5); scr[kk * 33 + (lane & 31)] = valid ? W[(size_t)(k0 + kk) * N + sc] : 0.0f; }
    asm volatile("s_waitcnt lgkmcnt(0)" ::: "memory");
    const int c = lane & 7;
#pragma unroll
    for (int j = 0; j < 4; ++j) { const int n = (lane >> 3) + 8 * j; const LAS float* s = scr + (8 * c) * 33 + n;
        u32x4 o; o.x = cvt_pk_bf16(s[0 * 33], s[1 * 33]); o.y = cvt_pk_bf16(s[2 * 33], s[3 * 33]); o.z = cvt_pk_bf16(s[4 * 33], s[5 * 33]); o.w = cvt_pk_bf16(s[6 * 33], s[7 * 33]);
        *(u32x4*)(WT + (size_t)(n0 + n) * K + k0 + 8 * c) = o; }
    asm volatile("s_waitcnt lgkmcnt(0)" ::: "memory");
}

#define XB_TMO      128
#define XB_XCNT(j)  (256  + 64 * (j))
#define XB_XSUB(j)  (1280 + 64 * (j))
#define XB_XGEN(j)  (2304 + 64 * (j))
#define XB_TOP      3328
#define XB_TOPGEN   3392
#define XCD_BAR_WORDS 3456
#define XB_SPIN_CAP (1u << 20)
__device__ __forceinline__ unsigned xb_ld(unsigned* p)              { return __hip_atomic_load(p, __ATOMIC_RELAXED, __HIP_MEMORY_SCOPE_AGENT); }
__device__ __forceinline__ unsigned xb_add(unsigned* p, unsigned v) { return __hip_atomic_fetch_add(p, v, __ATOMIC_RELAXED, __HIP_MEMORY_SCOPE_AGENT); }
__device__ __forceinline__ unsigned xb_xcc_id() { return (unsigned)__builtin_amdgcn_s_getreg((3 << 11) | 20) & 0xFu; }
#define XB_SPIN(cond, bar) do { unsigned _sp = 0; while (cond) { __builtin_amdgcn_s_sleep(1); \
    if ((++_sp & 255u) == 0u) { if (xb_ld(&(bar)[XB_TMO])) break; if (_sp > XB_SPIN_CAP) { atomicAdd(&(bar)[XB_TMO], 1u); break; } } } } while (0)
struct XcdBarrier { unsigned* bar; unsigned x; volatile LAS unsigned* st; };
__device__ __forceinline__ XcdBarrier xcd_barrier_post(unsigned* bar, volatile LAS unsigned* st) {
    XcdBarrier b; b.bar = bar; b.x = xb_xcc_id(); b.st = st;
    if (threadIdx.x == 0) (void)xb_add(&bar[XB_XCNT(b.x)], 1u);
    return b;
}
__device__ __forceinline__ void xcd_barrier_complete(unsigned* bar, unsigned x, unsigned& nloc, unsigned& nx) {
    const unsigned G = gridDim.x * gridDim.y * gridDim.z;
    unsigned sum, cnt, mine, sp = 0u;
    for (;;) {
        sum = 0u; cnt = 0u; mine = 0u;
#pragma unroll
        for (unsigned j = 0; j < 16; ++j) { const unsigned c = xb_ld(&bar[XB_XCNT(j)]); sum += c; cnt += (c > 0u) ? 1u : 0u; mine = (j == x) ? c : mine; }
        if (sum == G) break;
        __builtin_amdgcn_s_sleep(1);
        if ((++sp & 255u) == 0u) { if (xb_ld(&bar[XB_TMO])) break; if (sp > XB_SPIN_CAP) { atomicAdd(&bar[XB_TMO], 1u); break; } }
    }
    nloc = mine > 0u ? mine : 1u; nx = cnt > 0u ? cnt : 1u;
}
__device__ __forceinline__ void xcd_barrier(const XcdBarrier& b) {
    asm volatile("s_waitcnt vmcnt(0)" ::: "memory");
    __syncthreads();
    if (threadIdx.x == 0) {
        unsigned* bar = b.bar;
        __builtin_amdgcn_s_waitcnt(0);
        unsigned nloc = b.st[0], nx = b.st[1];
        if (nloc == 0u) { xcd_barrier_complete(bar, b.x, nloc, nx); b.st[0] = nloc; b.st[1] = nx; }
        const unsigned old = xb_add(&bar[XB_XSUB(b.x)], 1u);
        const unsigned gen = old / nloc;
        if (old + 1u == (gen + 1u) * nloc) {
            __builtin_amdgcn_fence(__ATOMIC_RELEASE, "agent");
            asm volatile("s_waitcnt vmcnt(0)" ::: "memory");
            const unsigned og = xb_add(&bar[XB_TOP], 1u);
            const unsigned tg = og / nx;
            if (og + 1u == (tg + 1u) * nx) xb_add(&bar[XB_TOPGEN], 1u);
            else XB_SPIN(xb_ld(&bar[XB_TOPGEN]) == tg, bar);
            __builtin_amdgcn_fence(__ATOMIC_ACQUIRE, "agent");
            xb_add(&bar[XB_XGEN(b.x)], 1u);
            asm volatile("s_waitcnt vmcnt(0)" ::: "memory");
        } else {
            XB_SPIN(xb_ld(&bar[XB_XGEN(b.x)]) == gen, bar);
            __builtin_amdgcn_fence(__ATOMIC_ACQUIRE, "agent");
            asm volatile("s_waitcnt vmcnt(0)" ::: "memory");
        }
    }
    __syncthreads();
}

struct Args { const float* in[18]; float* out; unsigned char* ws; };

__global__ void __launch_bounds__(NTHR, 2) fwd_megakernel(Args args) {
    extern __shared__ __attribute__((aligned(16))) unsigned char lds_raw[];
    LAS unsigned char* lds = (LAS unsigned char*)lds_raw;
    cg::grid_group grid = cg::this_grid();
    const int tid = threadIdx.x, lane = tid & 63, wave = __builtin_amdgcn_readfirstlane(tid >> 6);
    const int G = gridDim.x, bx = blockIdx.x;
    const int vcu = (G % 8 == 0) ? (bx % 8) * (G / 8) + bx / 8 : bx;
    const int gw = vcu * NWAVES + wave, NGW = G * NWAVES;
    const int gtid = vcu * NTHR + tid, NGT = G * NTHR;

    const float* x = args.in[0]; const float* cvec = args.in[1]; const float* w_cond = args.in[2]; const float* b_cond = args.in[3];
    const float* w_in = args.in[4]; const float* conv_a = args.in[5]; const float* kn_g = args.in[6]; const float* kn_b = args.in[7];
    const float* w_a = args.in[8]; const float* w_b = args.in[9]; const float* w_o = args.in[10]; const float* ln1_g = args.in[11]; const float* ln1_b = args.in[12];
    const float* w_up = args.in[13]; const float* conv_f = args.in[14]; const float* w_down = args.in[15]; const float* ln2_g = args.in[16]; const float* ln2_b = args.in[17];
    float* out = args.out; unsigned char* ws = args.ws;
    float* PART = (float*)(ws + WS_PART); float* MOD = (float*)(ws + WS_MOD);
    bf16_t* WIN_T = (bf16_t*)(ws + WS_WIN); bf16_t* WA_T = (bf16_t*)(ws + WS_WA); bf16_t* WB_T = (bf16_t*)(ws + WS_WB); bf16_t* WO_T = (bf16_t*)(ws + WS_WO);
    bf16_t* WUP_T = (bf16_t*)(ws + WS_WUP); bf16_t* WD_T = (bf16_t*)(ws + WS_WD);
    bf16_t* U = (bf16_t*)(ws + WS_U);
    bf16_t* CB = (bf16_t*)(ws + WS_CB); bf16_t* CC = (bf16_t*)(ws + WS_CC); bf16_t* CH = (bf16_t*)(ws + WS_CH); bf16_t* Q = (bf16_t*)(ws + WS_Q);
    bf16_t* GA = (bf16_t*)(ws + WS_GA); bf16_t* GB = (bf16_t*)(ws + WS_GB); bf16_t* KB = (bf16_t*)(ws + WS_K); bf16_t* VB = (bf16_t*)(ws + WS_V);
    bf16_t* VT = (bf16_t*)(ws + WS_VT); bf16_t* QI = (bf16_t*)(ws + WS_QI); bf16_t* KW = (bf16_t*)(ws + WS_KW); bf16_t* KIB = (bf16_t*)(ws + WS_KIB);
    float* WIF = (float*)(ws + WS_WIF); unsigned long long* MASK = (unsigned long long*)(ws + WS_MASK);
    float* Z = (float*)(ws + WS_Z); float* Z2 = (float*)(ws + WS_Z2); bf16_t* HA = (bf16_t*)(ws + WS_HA); bf16_t* HG = (bf16_t*)(ws + WS_HG);
    float* X1 = out; float* TMP = out;
    unsigned* BARW = (unsigned*)ws;
    volatile LAS unsigned* bst = (volatile LAS unsigned*)(lds + 131072);
    if (tid < 2) bst[tid] = 0u;
    if (bx == 0) for (int i = tid; i < XCD_BAR_WORDS; i += NTHR) __hip_atomic_store(BARW + i, 0u, __ATOMIC_RELAXED, __HIP_MEMORY_SCOPE_AGENT);

    {
        LAS float* cact = (LAS float*)lds;
        for (int i = tid; i < 2 * DM; i += NTHR) { const float c = cvec[i]; cact[i] = c / (1.0f + __expf(-c)); }
        __syncthreads();
        for (int item = gw; item < 8 * 192; item += NGW) {
            const int kc = item / 192, cb = item % 192, col = cb * 64 + (lane & 15) * 4, kq = lane >> 4;
            f32x4 a0 = {0.f, 0.f, 0.f, 0.f}, a1 = {0.f, 0.f, 0.f, 0.f};
            const float* wp = w_cond + (size_t)(kc * 256 + kq) * NMOD + col;
#pragma unroll 8
            for (int i = 0; i < 64; ++i) { const f32x4 w = *(const f32x4*)(wp + (size_t)(4 * i) * NMOD); const int k = kc * 256 + kq + 4 * i;
                const float s0 = cact[k], s1 = cact[DM + k]; a0 += s0 * w; a1 += s1 * w; }
#pragma unroll
            for (int j = 0; j < 4; ++j) { a0[j] += __shfl_xor(a0[j], 16); a0[j] += __shfl_xor(a0[j], 32); a1[j] += __shfl_xor(a1[j], 16); a1[j] += __shfl_xor(a1[j], 32); }
            if (lane < 16) { *(f32x4*)(PART + (size_t)(kc * 2 + 0) * NMOD + col) = a0; *(f32x4*)(PART + (size_t)(kc * 2 + 1) * NMOD + col) = a1; }
        }
        LAS float* scr = (LAS float*)(lds + 16384 + wave * 8448);
        for (int it = gw; it < 32 * (NPROJ / 32); it += NGW) transpose_item<true>(w_in, DM, 14416, NPROJ, WIN_T, scr, it, lane);
    }
    grid.sync();
    const XcdBarrier xbar = xcd_barrier_post(BARW, bst);

    {
        for (int idx = gtid; idx < 2 * NMOD; idx += NGT) { const int b = idx / NMOD, e = idx % NMOD; float s = b_cond[e];
#pragma unroll
            for (int kc = 0; kc < 8; ++kc) s += PART[(size_t)(kc * 2 + b) * NMOD + e];
            MOD[idx] = s; }
        for (int rb = vcu; rb < MT / 32; rb += G) {
            const int b = rb >> 7, col = (tid & 255) * 8, r0 = rb * 32 + (tid >> 8) * 16;
            f32x4 sh0 = *(const f32x4*)(b_cond + col), sh1 = *(const f32x4*)(b_cond + col + 4), sc0 = *(const f32x4*)(b_cond + DM + col), sc1 = *(const f32x4*)(b_cond + DM + col + 4);
#pragma unroll
            for (int kc = 0; kc < 8; ++kc) { const float* p = PART + (size_t)(kc * 2 + b) * NMOD + col;
                sh0 += *(const f32x4*)(p); sh1 += *(const f32x4*)(p + 4); sc0 += *(const f32x4*)(p + DM); sc1 += *(const f32x4*)(p + DM + 4); }
#pragma unroll 4
            for (int r = 0; r < 16; ++r) { const size_t off = (size_t)(r0 + r) * DM + col;
                const f32x4 x0 = *(const f32x4*)(x + off), x1 = *(const f32x4*)(x + off + 4);
                f32x4 u0, u1;
#pragma unroll
                for (int j = 0; j < 4; ++j) { u0[j] = x0[j] * (1.0f + sc0[j]) + sh0[j]; u1[j] = x1[j] * (1.0f + sc1[j]) + sh1[j]; }
                u32x4 w; w.x = cvt_pk_bf16(u0[0], u0[1]); w.y = cvt_pk_bf16(u0[2], u0[3]); w.z = cvt_pk_bf16(u1[0], u1[1]); w.w = cvt_pk_bf16(u1[2], u1[3]);
                *(u32x4*)(U + off) = w; }
        }
        LAS float* scr = (LAS float*)(lds + wave * 8448);
        constexpr int I_SQ = 32 * 64, I_UP = 32 * 352, I_DN = 88 * 64;
        for (int it = gw; it < 3 * I_SQ + I_UP + I_DN; it += NGW) {
            int r = it;
            if (r < I_SQ) { transpose_item<false>(w_a, DM, DM, DM, WA_T, scr, r, lane); continue; } r -= I_SQ;
            if (r < I_SQ) { transpose_item<false>(w_b, DM, DM, DM, WB_T, scr, r, lane); continue; } r -= I_SQ;
            if (r < I_SQ) { transpose_item<false>(w_o, DM, DM, DM, WO_T, scr, r, lane); continue; } r -= I_SQ;
            if (r < I_UP) { transpose_item<false>(w_up, DM, 2 * DFF, 2 * DFF, WUP_T, scr, r, lane); continue; } r -= I_UP;
            transpose_item<false>(w_down, DFF, DM, DM, WD_T, scr, r, lane);
        }
    }
    xcd_barrier(xbar);

    {
        pg8::Gemm g{U, WIN_T, MT, NPROJ, DM}; pg8::StaticOrder S; S.init(MT, NPROJ, G, bx);
        EpiProj E{ws};
        pg8::gemm_phase<EpiProj>(lds, g, S, E);
    }
    xcd_barrier(xbar);

    {
        for (int un = gtid; un < (MT / 16) * 256; un += NGT) {
            const int cg8 = un & 255, rb = un >> 8, col = cg8 * 8, m0 = rb * 16, t0 = m0 & (SEQ - 1);
            float w0[8], w1[8], w2[8], p1[8], p2[8];
#pragma unroll
            for (int j = 0; j < 8; ++j) { w0[j] = conv_a[col + j]; w1[j] = conv_a[DM + col + j]; w2[j] = conv_a[2 * DM + col + j]; p1[j] = 0.f; p2[j] = 0.f; }
            if (t0 != 0) {
                const u32x4 c2 = *(const u32x4*)(CC + (size_t)(m0 - 2) * DM + col), h2 = *(const u32x4*)(CH + (size_t)(m0 - 2) * DM + col);
                const u32x4 c1 = *(const u32x4*)(CC + (size_t)(m0 - 1) * DM + col), h1 = *(const u32x4*)(CH + (size_t)(m0 - 1) * DM + col);
#pragma unroll
                for (int j = 0; j < 4; ++j) { p2[2 * j] = bflo(c2[j]) * bflo(h2[j]); p2[2 * j + 1] = bfhi(c2[j]) * bfhi(h2[j]); p1[2 * j] = bflo(c1[j]) * bflo(h1[j]); p1[2 * j + 1] = bfhi(c1[j]) * bfhi(h1[j]); }
            }
#pragma unroll 4
            for (int r = 0; r < 16; ++r) { const size_t off = (size_t)(m0 + r) * DM + col;
                const u32x4 cc = *(const u32x4*)(CC + off), ch = *(const u32x4*)(CH + off), cb = *(const u32x4*)(CB + off);
                float p0[8], y[8];
#pragma unroll
                for (int j = 0; j < 4; ++j) { p0[2 * j] = bflo(cc[j]) * bflo(ch[j]); p0[2 * j + 1] = bfhi(cc[j]) * bfhi(ch[j]); }
#pragma unroll
                for (int j = 0; j < 8; ++j) { const float cv = w0[j] * p2[j] + w1[j] * p1[j] + w2[j] * p0[j]; const float cbv = (j & 1) ? bfhi(cb[j >> 1]) : bflo(cb[j >> 1]); y[j] = cbv * cv; p2[j] = p1[j]; p1[j] = p0[j]; }
                u32x4 w; w.x = cvt_pk_bf16(y[0], y[1]); w.y = cvt_pk_bf16(y[2], y[3]); w.z = cvt_pk_bf16(y[4], y[5]); w.w = cvt_pk_bf16(y[6], y[7]);
                *(u32x4*)(CB + off) = w; }
        }
        for (int un = vcu; un < NB * 4 * 64; un += G) {
            const int sb = un & 63, n = (un >> 6) & 3, b = un >> 8;
            LAS unsigned short* tl = (LAS unsigned short*)lds;
            __syncthreads();
#pragma unroll
            for (int j = 0; j < 2; ++j) { const int q = tid + 512 * j, row = q >> 4, ch = q & 15;
                const u32x4 v = *(const u32x4*)(VB + (size_t)(b * SEQ + sb * 64 + row) * 512 + n * 128 + ch * 8);
                LAS unsigned* d = (LAS unsigned*)(tl + row * 130 + ch * 8); d[0] = v.x; d[1] = v.y; d[2] = v.z; d[3] = v.w; }
            __syncthreads();
#pragma unroll
            for (int j = 0; j < 2; ++j) { const int q = tid + 512 * j, s8 = q & 7, d = q >> 3;
                unsigned e[8];
#pragma unroll
                for (int k = 0; k < 8; ++k) e[k] = tl[(s8 * 8 + k) * 130 + d];
                u32x4 w; w.x = e[0] | (e[1] << 16); w.y = e[2] | (e[3] << 16); w.z = e[4] | (e[5] << 16); w.w = e[6] | (e[7] << 16);
                *(u32x4*)(VT + ((size_t)((b * 4 + n) * 128 + d)) * SEQ + sb * 64 + s8 * 8) = w; }
        }
        __syncthreads();
        for (int m = gtid; m < MT; m += NGT) {
            float v[64]; float s = 0.f;
#pragma unroll
            for (int j = 0; j < 8; ++j) { const u32x4 w = *(const u32x4*)(KW + (size_t)m * 256 + j * 8);
#pragma unroll
                for (int k = 0; k < 4; ++k) { v[j * 8 + 2 * k] = bflo(w[k]); v[j * 8 + 2 * k + 1] = bfhi(w[k]); } }
#pragma unroll
            for (int j = 0; j < 64; ++j) s += v[j];
            const float mu = s * (1.0f / 64.0f); float s2 = 0.f;
#pragma unroll
            for (int j = 0; j < 64; ++j) { v[j] -= mu; s2 += v[j] * v[j]; }
            const float rstd = rsqrtf(s2 * (1.0f / 64.0f) + LN_EPS);
#pragma unroll
            for (int j = 0; j < 8; ++j) { u32x4 w;
#pragma unroll
                for (int k = 0; k < 4; ++k) { const int e = j * 8 + 2 * k; w[k] = cvt_pk_bf16(v[e] * rstd * kn_g[e] + kn_b[e], v[e + 1] * rstd * kn_g[e + 1] + kn_b[e + 1]); }
                *(u32x4*)(KIB + (size_t)m * 64 + j * 8) = w; }
#pragma unroll
            for (int j = 0; j < 2; ++j) { const u32x4 w = *(const u32x4*)(KW + (size_t)m * 256 + 64 + j * 8);
                f32x4 a, b2; a[0] = bflo(w.x); a[1] = bfhi(w.x); a[2] = bflo(w.y); a[3] = bfhi(w.y); b2[0] = bflo(w.z); b2[1] = bfhi(w.z); b2[2] = bflo(w.w); b2[3] = bfhi(w.w);
                *(f32x4*)(WIF + (size_t)m * 16 + j * 8) = a; *(f32x4*)(WIF + (size_t)m * 16 + j * 8 + 4) = b2; }
        }
    }
    xcd_barrier(xbar);

    for (int wq = gw; wq < 2048; wq += NGW) {
        const int c0 = wq >> 5, jt = wq & 31;
        for (int r = 0; r < 4; ++r) {
            const int b = r & 1, hh = r >> 1, tok = jt + 32 * hh, c = hh ? 63 - c0 : c0;
            const int m = b * SEQ + 64 * c + tok, nblk = c + 1;
            const bf16_t* qp = QI + (size_t)m * 1024 + (lane & 15) * 64 + (lane >> 4) * 8;
            const bf16x8 a0 = *(const bf16x8*)(qp), a1 = *(const bf16x8*)(qp + 32);
            const f32x4 w4 = *(const f32x4*)(WIF + (size_t)m * 16 + (lane >> 4) * 4);
            const bool b0 = (lane & 16) != 0, b1 = (lane & 32) != 0;
            unsigned sc[64];
            const bf16_t* kbase = KIB + (size_t)(b * SEQ + (lane & 15)) * 64 + (lane >> 4) * 8;
#pragma unroll
            for (int i = 0; i < 64; ++i) {
                unsigned key = 0u;
                if (i < nblk) {
                    float v[4];
#pragma unroll
                    for (int g = 0; g < 4; ++g) {
                        const bf16_t* kp = kbase + (size_t)(64 * i + 16 * g) * 64;
                        const bf16x8 k0 = *(const bf16x8*)(kp), k1 = *(const bf16x8*)(kp + 32);
                        f32x4 acc = {0.f, 0.f, 0.f, 0.f};
                        acc = __builtin_amdgcn_mfma_f32_16x16x32_bf16(a0, k0, acc, 0, 0, 0);
                        acc = __builtin_amdgcn_mfma_f32_16x16x32_bf16(a1, k1, acc, 0, 0, 0);
                        v[g] = w4[0] * fmaxf(acc[0], 0.f) + w4[1] * fmaxf(acc[1], 0.f) + w4[2] * fmaxf(acc[2], 0.f) + w4[3] * fmaxf(acc[3], 0.f);
                    }
                    const float s0 = b0 ? v[0] : v[1], s1 = b0 ? v[2] : v[3];
                    const float r0 = __shfl_xor(s0, 16), r1 = __shfl_xor(s1, 16);
                    const float t0 = (b0 ? v[1] : v[0]) + r0, t1 = (b0 ? v[3] : v[2]) + r1;
                    const float s2 = b1 ? t0 : t1;
                    const float r2 = __shfl_xor(s2, 32);
                    const float fin = (b1 ? t1 : t0) + r2;
                    const unsigned ub = __float_as_uint(fin);
                    key = (ub & 0x80000000u) ? ~ub : (ub | 0x80000000u);
                }
                sc[i] = key;
            }
            unsigned long long myword = 0ull;
            if (nblk <= 4) {
                if (lane < nblk) myword = ~0ull;
            } else {
                unsigned T = 0u;
                for (int bit = 31; bit >= 0; --bit) {
                    const unsigned cand = T | (1u << bit);
                    int cnt = 0;
#pragma unroll
                    for (int g8 = 0; g8 < 8; ++g8) {
                        if (g8 * 8 < nblk) {
#pragma unroll
                            for (int e = 0; e < 8; ++e) cnt += __popcll(__ballot(sc[g8 * 8 + e] >= cand));
                        }
                    }
                    if (cnt >= 256) T = cand;
                }
                int cgt = 0;
#pragma unroll
                for (int i = 0; i < 64; ++i) cgt += __popcll(__ballot(sc[i] > T));
                int need = 256 - cgt;
#pragma unroll
                for (int i = 0; i < 64; ++i) {
                    if (i < nblk) {
                        const unsigned long long gt = __ballot(sc[i] > T), eq = __ballot(sc[i] == T);
                        unsigned long long sel = 0ull;
                        if (eq != 0ull && need > 0) {
                            const int ne = __popcll(eq);
                            if (ne <= need) { sel = eq; need -= ne; }
                            else { unsigned long long tmp = eq; for (int k = 0; k < need; ++k) { const unsigned long long low = tmp & (0ull - tmp); sel |= low; tmp ^= low; } need = 0; }
                        }
                        const unsigned long long word = gt | sel;
                        if (lane == i) myword = word;
                    }
                }
            }
            MASK[(size_t)m * 64 + lane] = myword;
        }
    }
    xcd_barrier(xbar);

    for (int it0 = vcu; it0 < 256; it0 += G) {
        const int cc0 = it0 & 31, n = (it0 >> 5) & 3, b = it0 >> 7;
        for (int half = 0; half < 2; ++half) {
            const int c = half ? 63 - cc0 : cc0, nblk = c + 1;
            const int h = lane >> 5, r = lane & 31;
            const int hq = 4 * n + (wave >> 1), th = wave & 1;
            const int mq = b * SEQ + 64 * c + 32 * th + r;
            bf16x8 qf[8];
            { const bf16_t* qp = Q + (size_t)mq * DM + hq * 128 + 8 * h;
#pragma unroll
              for (int ks = 0; ks < 8; ++ks) qf[ks] = *(const bf16x8*)(qp + ks * 16); }
            f32x16 o[4];
#pragma unroll
            for (int dt = 0; dt < 4; ++dt)
#pragma unroll
                for (int i = 0; i < 16; ++i) o[dt][i] = 0.f;
            float mrun = -INFINITY, lrun = 0.f;
            const int kq0 = tid, kq1 = tid + 512;
            const bf16_t* ksrc0 = KB + (size_t)(b * SEQ + (kq0 >> 4)) * 512 + n * 128 + (kq0 & 15) * 8;
            const bf16_t* ksrc1 = KB + (size_t)(b * SEQ + (kq1 >> 4)) * 512 + n * 128 + (kq1 & 15) * 8;
            const int kd0 = (kq0 >> 4) * 272 + (kq0 & 15) * 16, kd1 = (kq1 >> 4) * 272 + (kq1 & 15) * 16;
            const bf16_t* vsrc0 = VT + ((size_t)((b * 4 + n) * 128 + (kq0 >> 3))) * SEQ + (kq0 & 7) * 8;
            const bf16_t* vsrc1 = VT + ((size_t)((b * 4 + n) * 128 + (kq1 >> 3))) * SEQ + (kq1 & 7) * 8;
            const int vd0 = 17408 + (kq0 >> 3) * 136 + (kq0 & 7) * 16, vd1 = 17408 + (kq1 >> 3) * 136 + (kq1 & 7) * 16;
            u32x4 pk0, pk1, pv0, pv1;
            pk0 = *(const u32x4*)(ksrc0); pk1 = *(const u32x4*)(ksrc1); pv0 = *(const u32x4*)(vsrc0); pv1 = *(const u32x4*)(vsrc1);
            {
                *(LAS u32x4*)(lds + kd0) = pk0; *(LAS u32x4*)(lds + kd1) = pk1;
                *(LAS u32x2*)(lds + vd0) = (u32x2){pv0.x, pv0.y}; *(LAS u32x2*)(lds + vd0 + 8) = (u32x2){pv0.z, pv0.w};
                *(LAS u32x2*)(lds + vd1) = (u32x2){pv1.x, pv1.y}; *(LAS u32x2*)(lds + vd1 + 8) = (u32x2){pv1.z, pv1.w};
            }
            __syncthreads();
            const unsigned long long* mrow = MASK + (size_t)mq * 64;
            for (int kt = 0; kt < nblk; ++kt) {
                const int buf = (kt & 1) * 34816;
                const bool more = (kt + 1 < nblk);
                if (more) { const size_t ko = (size_t)(kt + 1) * 64 * 512, vo = (size_t)(kt + 1) * 64;
                    pk0 = *(const u32x4*)(ksrc0 + ko); pk1 = *(const u32x4*)(ksrc1 + ko); pv0 = *(const u32x4*)(vsrc0 + vo); pv1 = *(const u32x4*)(vsrc1 + vo); }
                const unsigned long long mw = mrow[kt];
                f32x16 st[2];
#pragma unroll
                for (int sub = 0; sub < 2; ++sub) {
#pragma unroll
                    for (int i = 0; i < 16; ++i) st[sub][i] = 0.f;
                    const LAS unsigned char* kb = lds + buf + (32 * sub + r) * 272 + h * 16;
#pragma unroll
                    for (int ks = 0; ks < 8; ++ks) { const bf16x8 kf = *(const LAS bf16x8*)(kb + ks * 32);
                        st[sub] = __builtin_amdgcn_mfma_f32_32x32x16_bf16(kf, qf[ks], st[sub], 0, 0, 0); }
                }
                constexpr float CSC = 0.08838834764831845f * 1.4426950408889634f;
                float mx = -INFINITY;
#pragma unroll
                for (int sub = 0; sub < 2; ++sub) { const unsigned w = (unsigned)(sub ? (mw >> 32) : (mw & 0xffffffffull)) >> (4 * h);
#pragma unroll
                    for (int i = 0; i < 16; ++i) { const int pos = (i & 3) + 8 * (i >> 2);
                        const float sv = ((w >> pos) & 1u) ? st[sub][i] * CSC : -INFINITY; st[sub][i] = sv; mx = fmaxf(mx, sv); } }
                mx = fmaxf(mx, __shfl_xor(mx, 32));
                const float mnew = fmaxf(mrun, mx), msafe = (mnew == -INFINITY) ? 0.f : mnew;
                const float alpha = __builtin_amdgcn_exp2f(mrun - msafe);
                float ls = 0.f;
#pragma unroll
                for (int sub = 0; sub < 2; ++sub)
#pragma unroll
                    for (int i = 0; i < 16; ++i) { const float p = __builtin_amdgcn_exp2f(st[sub][i] - msafe); st[sub][i] = p; ls += p; }
                lrun = lrun * alpha + ls; mrun = mnew;
#pragma unroll
                for (int dt = 0; dt < 4; ++dt)
#pragma unroll
                    for (int i = 0; i < 16; ++i) o[dt][i] *= alpha;
#pragma unroll
                for (int sub = 0; sub < 2; ++sub)
#pragma unroll
                    for (int s = 0; s < 2; ++s) {
                        u32x4 pw; pw.x = cvt_pk_bf16(st[sub][8 * s + 0], st[sub][8 * s + 1]); pw.y = cvt_pk_bf16(st[sub][8 * s + 2], st[sub][8 * s + 3]);
                        pw.z = cvt_pk_bf16(st[sub][8 * s + 4], st[sub][8 * s + 5]); pw.w = cvt_pk_bf16(st[sub][8 * s + 6], st[sub][8 * s + 7]);
                        const bf16x8 pf = __builtin_bit_cast(bf16x8, pw);
#pragma unroll
                        for (int dt = 0; dt < 4; ++dt) {
                            const LAS unsigned char* vp = lds + buf + 17408 + (32 * dt + r) * 136 + (32 * sub + 16 * s + 4 * h) * 2;
                            const u32x2 lo = *(const LAS u32x2*)(vp), hi = *(const LAS u32x2*)(vp + 16);
                            const u32x4 vw = {lo.x, lo.y, hi.x, hi.y};
                            o[dt] = __builtin_amdgcn_mfma_f32_32x32x16_bf16(__builtin_bit_cast(bf16x8, vw), pf, o[dt], 0, 0, 0);
                        }
                    }
                if (more) { const int nb2 = ((kt + 1) & 1) * 34816;
                    *(LAS u32x4*)(lds + nb2 + kd0) = pk0; *(LAS u32x4*)(lds + nb2 + kd1) = pk1;
                    *(LAS u32x2*)(lds + nb2 + vd0) = (u32x2){pv0.x, pv0.y}; *(LAS u32x2*)(lds + nb2 + vd0 + 8) = (u32x2){pv0.z, pv0.w};
                    *(LAS u32x2*)(lds + nb2 + vd1) = (u32x2){pv1.x, pv1.y}; *(LAS u32x2*)(lds + nb2 + vd1 + 8) = (u32x2){pv1.z, pv1.w}; }
                __syncthreads();
            }
            const float ltot = lrun + __shfl_xor(lrun, 32);
            const float inv = 1.0f / ltot;
            bf16_t* op = Q + (size_t)mq * DM + hq * 128 + 4 * h;
#pragma unroll
            for (int dt = 0; dt < 4; ++dt)
#pragma unroll
                for (int g4 = 0; g4 < 4; ++g4) {
                    u32x2 w; w.x = cvt_pk_bf16(o[dt][4 * g4 + 0] * inv, o[dt][4 * g4 + 1] * inv); w.y = cvt_pk_bf16(o[dt][4 * g4 + 2] * inv, o[dt][4 * g4 + 3] * inv);
                    *(u32x2*)(op + 32 * dt + 8 * g4) = w; }
        }
    }
    xcd_barrier(xbar);

    {
        pg8::StaticOrder S; S.init(MT, DM, G, bx);
        { pg8::Gemm g{CB, WA_T, MT, DM, DM}; EpiGate1 E{GA, TMP}; pg8::gemm_phase<EpiGate1>(lds, g, S, E); }
        { pg8::Gemm g{Q, WB_T, MT, DM, DM}; EpiGate2 E{GB, TMP, U}; pg8::gemm_phase<EpiGate2>(lds, g, S, E); }
    }
    xcd_barrier(xbar);

    {
        pg8::Gemm g{U, WO_T, MT, DM, DM}; pg8::StaticOrder S; S.init(MT, DM, G, bx);
        EpiRes E{x, MOD + 2 * DM, Z};
        pg8::gemm_phase<EpiRes>(lds, g, S, E);
    }
    xcd_barrier(xbar);

    for (int m = gw; m < MT; m += NGW) {
        const int b = m >> 12;
        const float* zr = Z + (size_t)m * DM;
        f32x4 v[8]; float s = 0.f;
#pragma unroll
        for (int j = 0; j < 8; ++j) { v[j] = *(const f32x4*)(zr + j * 256 + lane * 4); s += (v[j][0] + v[j][1]) + (v[j][2] + v[j][3]); }
        const float mu = wave_sum(s) * (1.0f / DM); float s2 = 0.f;
#pragma unroll
        for (int j = 0; j < 8; ++j) { v[j] = v[j] - mu; s2 += (v[j][0] * v[j][0] + v[j][1] * v[j][1]) + (v[j][2] * v[j][2] + v[j][3] * v[j][3]); }
        const float rstd = rsqrtf(wave_sum(s2) * (1.0f / DM) + LN_EPS);
        const float* shf = MOD + (size_t)b * NMOD + 3 * DM; const float* scf = MOD + (size_t)b * NMOD + 4 * DM;
#pragma unroll
        for (int j = 0; j < 8; ++j) { const int col = j * 256 + lane * 4;
            const f32x4 gg = *(const f32x4*)(ln1_g + col), bb = *(const f32x4*)(ln1_b + col), sc4 = *(const f32x4*)(scf + col), sh4 = *(const f32x4*)(shf + col);
            f32x4 y, uu;
#pragma unroll
            for (int k = 0; k < 4; ++k) { y[k] = v[j][k] * rstd * gg[k] + bb[k]; uu[k] = y[k] * (1.0f + sc4[k]) + sh4[k]; }
            *(f32x4*)(X1 + (size_t)m * DM + col) = y;
            u32x2 w; w.x = cvt_pk_bf16(uu[0], uu[1]); w.y = cvt_pk_bf16(uu[2], uu[3]);
            *(u32x2*)(U + (size_t)m * DM + col) = w; }
    }
    xcd_barrier(xbar);

    {
        pg8::Gemm g{U, WUP_T, MT, 2 * DFF, DM}; pg8::StaticOrder S; S.init(MT, 2 * DFF, G, bx);
        EpiUp E{HA, HG};
        pg8::gemm_phase<EpiUp>(lds, g, S, E);
    }
    xcd_barrier(xbar);

    for (int un = gtid; un < (MT / 16) * (DFF / 8); un += NGT) {
        const int cg8 = un % (DFF / 8), rb = un / (DFF / 8), col = cg8 * 8, m0 = rb * 16, t0 = m0 & (SEQ - 1);
        float w0[8], w1[8], w2[8], p1[8], p2[8];
#pragma unroll
        for (int j = 0; j < 8; ++j) { w0[j] = conv_f[col + j]; w1[j] = conv_f[DFF + col + j]; w2[j] = conv_f[2 * DFF + col + j]; p1[j] = 0.f; p2[j] = 0.f; }
        if (t0 != 0) {
            const u32x4 a2 = *(const u32x4*)(HA + (size_t)(m0 - 2) * DFF + col), a1 = *(const u32x4*)(HA + (size_t)(m0 - 1) * DFF + col);
#pragma unroll
            for (int j = 0; j < 4; ++j) { p2[2 * j] = bflo(a2[j]); p2[2 * j + 1] = bfhi(a2[j]); p1[2 * j] = bflo(a1[j]); p1[2 * j + 1] = bfhi(a1[j]); }
        }
#pragma unroll 4
        for (int r = 0; r < 16; ++r) { const size_t off = (size_t)(m0 + r) * DFF + col;
            const u32x4 a = *(const u32x4*)(HA + off), gt = *(const u32x4*)(HG + off);
            float p0[8], y[8];
#pragma unroll
            for (int j = 0; j < 4; ++j) { p0[2 * j] = bflo(a[j]); p0[2 * j + 1] = bfhi(a[j]); }
#pragma unroll
            for (int j = 0; j < 8; ++j) { const float cv = w0[j] * p2[j] + w1[j] * p1[j] + w2[j] * p0[j];
                const float inner = 0.7978845608028654f * (cv + 0.044715f * cv * cv * cv);
                const float ge = cv * __builtin_amdgcn_rcpf(1.0f + __expf(-2.0f * inner));
                const float gv = (j & 1) ? bfhi(gt[j >> 1]) : bflo(gt[j >> 1]); y[j] = ge * gv; p2[j] = p1[j]; p1[j] = p0[j]; }
            u32x4 w; w.x = cvt_pk_bf16(y[0], y[1]); w.y = cvt_pk_bf16(y[2], y[3]); w.z = cvt_pk_bf16(y[4], y[5]); w.w = cvt_pk_bf16(y[6], y[7]);
            *(u32x4*)(HG + off) = w; }
    }
    xcd_barrier(xbar);

    {
        pg8::Gemm g{HG, WD_T, MT, DM, DFF}; pg8::StaticOrder S; S.init(MT, DM, G, bx);
        EpiRes E{X1, MOD + 5 * DM, Z2};
        pg8::gemm_phase<EpiRes>(lds, g, S, E);
    }
    xcd_barrier(xbar);

    for (int m = gw; m < MT; m += NGW) {
        const float* zr = Z2 + (size_t)m * DM;
        f32x4 v[8]; float s = 0.f;
#pragma unroll
        for (int j = 0; j < 8; ++j) { v[j] = *(const f32x4*)(zr + j * 256 + lane * 4); s += (v[j][0] + v[j][1]) + (v[j][2] + v[j][3]); }
        const float mu = wave_sum(s) * (1.0f / DM); float s2 = 0.f;
#pragma unroll
        for (int j = 0; j < 8; ++j) { v[j] = v[j] - mu; s2 += (v[j][0] * v[j][0] + v[j][1] * v[j][1]) + (v[j][2] * v[j][2] + v[j][3] * v[j][3]); }
        const float rstd = rsqrtf(wave_sum(s2) * (1.0f / DM) + LN_EPS);
#pragma unroll
        for (int j = 0; j < 8; ++j) { const int col = j * 256 + lane * 4;
            const f32x4 gg = *(const f32x4*)(ln2_g + col), bb = *(const f32x4*)(ln2_b + col);
            f32x4 y;
#pragma unroll
            for (int k = 0; k < 4; ++k) y[k] = v[j][k] * rstd * gg[k] + bb[k];
            *(f32x4*)(out + (size_t)m * DM + col) = y; }
    }
}

extern "C" void kernel_launch(void* const* d_in, const int* in_sizes, int n_in, void* d_out, int out_size, void* d_ws, size_t ws_size, hipStream_t stream) {
    static int grid_blocks = 0;
    if (grid_blocks == 0) {
        if (n_in != 18 || ws_size < WS_END) { fprintf(stderr, "kernel_launch: unexpected n_in %d or ws_size %zu (< %zu)\n", n_in, ws_size, (size_t)WS_END); grid_blocks = -1; return; }
        int dev = 0, cus = 0, per_cu = 0;
        hipGetDevice(&dev);
        hipDeviceGetAttribute(&cus, hipDeviceAttributeMultiprocessorCount, dev);
        if (hipFuncSetAttribute((const void*)fwd_megakernel, hipFuncAttributeMaxDynamicSharedMemorySize, LDS_BYTES) != hipSuccess) { fprintf(stderr, "kernel_launch: hipFuncSetAttribute failed\n"); grid_blocks = -1; return; }
        hipOccupancyMaxActiveBlocksPerMultiprocessor(&per_cu, (const void*)fwd_megakernel, NTHR, LDS_BYTES);
        if (per_cu < 1) { fprintf(stderr, "kernel_launch: occupancy query says %d\n", per_cu); per_cu = 1; }
        (void)hipGetLastError();
        grid_blocks = cus * per_cu;
    }
    if (grid_blocks < 0) return;
    Args a{};
    for (int i = 0; i < 18; ++i) a.in[i] = (const float*)d_in[i];
    a.out = (float*)d_out; a.ws = (unsigned char*)d_ws;
    void* kargs[] = {&a};
    hipError_t e = hipLaunchCooperativeKernel((const void*)fwd_megakernel, dim3(grid_blocks), dim3(NTHR), kargs, LDS_BYTES, stream);
    if (e != hipSuccess) fprintf(stderr, "cooperative launch failed: %s (grid %d)\n", hipGetErrorString(e), grid_blocks);
}
```

```cpp
#include <hip/hip_runtime.h>
#include <hip/hip_cooperative_groups.h>
#include <cstdio>
namespace cg = cooperative_groups;

#define LAS __attribute__((address_space(3)))
typedef unsigned short bf16_t;
typedef short bf16x8 __attribute__((ext_vector_type(8)));
typedef float f32x4 __attribute__((ext_vector_type(4)));
typedef float f32x16 __attribute__((ext_vector_type(16)));
typedef unsigned u32x4 __attribute__((ext_vector_type(4)));
typedef unsigned u32x2 __attribute__((ext_vector_type(2)));

#ifndef REP_P0
#define REP_P0 1
#endif
#ifndef REP_P1
#define REP_P1 1
#endif
#ifndef REP_P4
#define REP_P4 1
#endif
#ifndef REP_P5
#define REP_P5 1
#endif
constexpr int NB = 2, SEQ = 4096, DM = 2048, MT = NB * SEQ;
constexpr int NPROJ = 14592;
constexpr int DFF = 5632, NMOD = 12288;
constexpr float ALPHA = 1.189207115002721f;
constexpr float LN_EPS = 1e-5f;
constexpr int NWAVES = 8, NTHR = 512;
constexpr int LDS_BYTES = 147456;

constexpr size_t al256(size_t x) { return (x + 255) & ~(size_t)255; }
constexpr size_t WS_PART = 1u << 20;
constexpr size_t WS_MOD  = WS_PART + al256((size_t)8 * 2 * NMOD * 4);
constexpr size_t WS_WIN  = WS_MOD + al256((size_t)2 * NMOD * 4);
constexpr size_t WS_WA   = WS_WIN + (size_t)NPROJ * DM * 2;
constexpr size_t WS_WB   = WS_WA + (size_t)DM * DM * 2;
constexpr size_t WS_WO   = WS_WB + (size_t)DM * DM * 2;
constexpr size_t WS_WUP  = WS_WO + (size_t)DM * DM * 2;
constexpr size_t WS_WD   = WS_WUP + (size_t)2 * DFF * DM * 2;
constexpr size_t WS_U    = WS_WD + (size_t)DM * DFF * 2;
constexpr size_t ACT     = (size_t)MT * DM * 2;
constexpr size_t WS_CB   = WS_U + ACT;
constexpr size_t WS_CC   = WS_CB + ACT;
constexpr size_t WS_CH   = WS_CC + ACT;
constexpr size_t WS_Q    = WS_CH + ACT;
constexpr size_t WS_GA   = WS_Q + ACT;
constexpr size_t WS_GB   = WS_GA + ACT;
constexpr size_t WS_K    = WS_GB + ACT;
constexpr size_t WS_V    = WS_K + (size_t)MT * 512 * 2;
constexpr size_t WS_VT   = WS_V + (size_t)MT * 512 * 2;
constexpr size_t WS_QI   = WS_VT + (size_t)MT * 512 * 2;
constexpr size_t WS_KW   = WS_QI + (size_t)MT * 1024 * 2;
constexpr size_t WS_KIB  = WS_KW + (size_t)MT * 256 * 2;
constexpr size_t WS_WIF  = WS_KIB + (size_t)MT * 64 * 2;
constexpr size_t WS_MASK = WS_WIF + (size_t)MT * 16 * 4;
constexpr size_t WS_END  = WS_MASK + (size_t)MT * 64 * 8;
constexpr size_t WS_Z    = WS_CC;
constexpr size_t WS_HA   = WS_CB;
constexpr size_t WS_HG   = WS_CB + (size_t)MT * DFF * 2;
constexpr size_t WS_Z2   = WS_CB;
static_assert(WS_HG + (size_t)MT * DFF * 2 <= WS_K, "up-proj overlay fits in the proj region");

__device__ __forceinline__ unsigned cvt_pk_bf16(float lo, float hi) { unsigned r; asm volatile("v_cvt_pk_bf16_f32 %0, %1, %2" : "=v"(r) : "v"(lo), "v"(hi)); return r; }
__device__ __forceinline__ float bflo(unsigned w) { return __uint_as_float(w << 16); }
__device__ __forceinline__ float bfhi(unsigned w) { return __uint_as_float(w & 0xffff0000u); }
__device__ __forceinline__ float sigmoidf_(float g) { return __builtin_amdgcn_rcpf(1.0f + __expf(-g)); }
__device__ __forceinline__ float wave_sum(float v) {
#pragma unroll
    for (int o = 1; o < 64; o <<= 1) v += __shfl_xor(v, o);
    return v;
}

namespace pg8 {
constexpr int BM = 256, BK = 64, HALF = 128, HTB = HALF * BK * 2, STAGE_BYTES = 8 * HTB, NXCD = 8, WGM = 8;
__host__ __device__ __forceinline__ int lds_byte(int r, int c) { const int st = (r >> 4) * 2 + (c >> 5), rr = r & 15, cc = c & 31, ob = rr * 64 + cc * 2; return st * 1024 + (ob ^ (((ob >> 9) & 1) << 5)); }
__host__ __device__ __forceinline__ void stage_rc(int b, int& R, int& C) { const int st = b / 1024, sb = b % 1024, swz = sb ^ (((sb >> 9) & 1) << 5); R = (st >> 1) * 16 + swz / 64; C = (st & 1) * 32 + (swz % 64) / 2; }
__host__ __device__ __forceinline__ int perm32(int rho) { const int n = rho >> 4, i = rho & 15; return 8 * (i >> 2) + 4 * n + (i & 3); }
struct Unit { int pm, pn; };
struct Gemm { const bf16_t* A; const bf16_t* Bt; int M, N, K; };
struct StaticOrder {
    int nM, nN, nwg, G, c;
    __host__ __device__ void init(int M, int N, int G_, int c_) { nM = M / BM; nN = N / BM; nwg = nM * nN; G = G_; c = c_; }
    __host__ __device__ bool next(int i, Unit& u) const {
        const long L = (long)i * G + c; if (L >= nwg) return false;
        int wgid = (int)L; { const int q = nwg / NXCD, r = nwg % NXCD, xcd = wgid % NXCD, off = wgid / NXCD; wgid = (xcd < r ? xcd * (q + 1) : r * (q + 1) + (xcd - r) * q) + off; }
        const int nig = WGM * nN, gid = wgid / nig, fm = gid * WGM, gsz = (nM - fm) < WGM ? (nM - fm) : WGM;
        u.pm = fm + ((wgid % nig) % gsz); u.pn = (wgid % nig) / gsz; return true;
    }
};
template <class Epi>
__device__ __forceinline__ void gemm_phase(LAS unsigned char* lds, const Gemm g, const StaticOrder& S, const Epi& E) {
    const int tid = threadIdx.x, wid = __builtin_amdgcn_readfirstlane(tid >> 6), lane = tid & 63, wr = wid >> 2, wc = wid & 3, fr = lane & 15, fq = lane >> 4;
    const int K = g.K, nt = K / BK;
    unsigned voffA[2], voffB[2];
#pragma unroll
    for (int i = 0; i < 2; ++i) { int R, C; stage_rc(tid * 16 + i * 8192, R, C); const int Rb = (R & ~31) + perm32(R & 31);
        voffA[i] = (unsigned)(R * K + C) * 2u; voffB[i] = (unsigned)(Rb * K + C) * 2u; }
    const size_t kstep = (size_t)(BK * 2);
    const size_t hstep = (size_t)HALF * K * 2;
    const size_t tstep = 2 * hstep;
    const unsigned ldsw = (unsigned)wid * 1024u;
    const int aoff = lds_byte(wr * 64 + fr, fq * 8), boff = lds_byte(wc * 32 + fr, fq * 8);
#define PG8_SA(b, h) (((b) * 2 + (h)) * HTB)
#define PG8_SB(b, h) ((4 + (b) * 2 + (h)) * HTB)
#define PG8_STAGE(bufoff, gbase, voff) do { _Pragma("unroll") for (int _i = 0; _i < 2; ++_i) \
        __builtin_amdgcn_global_load_lds((const unsigned*)((const char*)(gbase) + (voff)[_i]), (LAS unsigned*)(lds + (bufoff) + ldsw + _i * 8192), 16, 0, 0); } while (0)
#define PG8_LDA(dst, b, h) do { _Pragma("unroll") for (int m = 0; m < 4; ++m) _Pragma("unroll") for (int k = 0; k < 2; ++k) dst[m][k] = *(const LAS bf16x8*)(lds + PG8_SA(b, h) + aoff + m * 2048 + k * 1024); } while (0)
#define PG8_LDB(dst, b, h) do { _Pragma("unroll") for (int n = 0; n < 2; ++n) _Pragma("unroll") for (int k = 0; k < 2; ++k) dst[n][k] = *(const LAS bf16x8*)(lds + PG8_SB(b, h) + boff + n * 2048 + k * 1024); } while (0)
#define PG8_MMA(ai, bj, At, Bt) do { __builtin_amdgcn_s_setprio(1); _Pragma("unroll") for (int m = 0; m < 4; ++m) _Pragma("unroll") for (int n = 0; n < 2; ++n) _Pragma("unroll") for (int k = 0; k < 2; ++k) \
        acc[ai][bj][m][n] = __builtin_amdgcn_mfma_f32_16x16x32_bf16(Bt[n][k], At[m][k], acc[ai][bj][m][n], 0, 0, 0); __builtin_amdgcn_s_setprio(0); } while (0)
#define PG8_WAIT_V(n) asm volatile("s_waitcnt vmcnt(" #n ")" ::: "memory")
#define PG8_WAIT_L(n) asm volatile("s_waitcnt lgkmcnt(" #n ")" ::: "memory")
#define PG8_BAR __builtin_amdgcn_s_barrier()
#define PG8_SCHED __builtin_amdgcn_sched_barrier(0)
    Unit cur, nxt; int ui = 0;
    if (!S.next(0, cur)) return;
    f32x4 acc[2][2][4][2];
#pragma unroll
    for (int a = 0; a < 2; ++a)
#pragma unroll
        for (int b = 0; b < 2; ++b)
#pragma unroll
            for (int m = 0; m < 4; ++m)
#pragma unroll
                for (int n = 0; n < 2; ++n) acc[a][b][m][n] = (f32x4){0.f, 0.f, 0.f, 0.f};
    bf16x8 At[4][2], B0[2][2], B1[2][2];
    const char* cA = (const char*)g.A + (size_t)cur.pm * tstep; const char* cB = (const char*)g.Bt + (size_t)cur.pn * tstep;
    PG8_STAGE(PG8_SB(0, 0), cB, voffB); PG8_STAGE(PG8_SA(0, 0), cA, voffA); PG8_STAGE(PG8_SB(0, 1), cB + hstep, voffB); PG8_STAGE(PG8_SA(0, 1), cA + hstep, voffA);
    if (wr == 1) PG8_BAR;
    PG8_WAIT_V(4); PG8_BAR;
    PG8_STAGE(PG8_SB(1, 0), cB + kstep, voffB); PG8_STAGE(PG8_SA(1, 0), cA + kstep, voffA); PG8_STAGE(PG8_SB(1, 1), cB + hstep + kstep, voffB);
    PG8_WAIT_V(6); PG8_BAR;
    for (;;) {
        const bool has_next = S.next(ui + 1, nxt);
        const char* nA = has_next ? (const char*)g.A + (size_t)nxt.pm * tstep : cA; const char* nB = has_next ? (const char*)g.Bt + (size_t)nxt.pn * tstep : cB;
        for (int t = 0; t < nt; t += 2) {
            const bool last = (t == nt - 2);
            const char* a1 = cA + (size_t)(t + 1) * kstep;
            const char* a2 = last ? nA : cA + (size_t)(t + 2) * kstep; const char* b2 = last ? nB : cB + (size_t)(t + 2) * kstep;
            const char* a3 = a2 + kstep; const char* b3 = b2 + kstep;
            PG8_LDB(B0, 0, 0); PG8_SCHED; PG8_LDA(At, 0, 0); PG8_STAGE(PG8_SA(1, 1), a1 + hstep, voffA);
            PG8_WAIT_L(8); PG8_BAR; PG8_WAIT_L(0); PG8_MMA(0, 0, At, B0); PG8_BAR; PG8_SCHED;
            PG8_LDB(B1, 0, 1); PG8_STAGE(PG8_SB(0, 0), b2, voffB);
            PG8_BAR; PG8_WAIT_L(0); PG8_MMA(0, 1, At, B1); PG8_BAR;
            PG8_LDA(At, 0, 1); PG8_STAGE(PG8_SA(0, 0), a2, voffA);
            PG8_BAR; PG8_WAIT_L(0); PG8_MMA(1, 0, At, B0); PG8_BAR; PG8_SCHED;
            PG8_STAGE(PG8_SB(0, 1), b2 + hstep, voffB);
            PG8_WAIT_V(6); PG8_BAR; PG8_MMA(1, 1, At, B1); PG8_BAR;
            PG8_LDB(B0, 1, 0); PG8_SCHED; PG8_LDA(At, 1, 0); PG8_STAGE(PG8_SA(0, 1), a2 + hstep, voffA);
            PG8_WAIT_L(8); PG8_BAR; PG8_WAIT_L(0); PG8_MMA(0, 0, At, B0); PG8_BAR; PG8_SCHED;
            PG8_LDB(B1, 1, 1); PG8_STAGE(PG8_SB(1, 0), b3, voffB);
            PG8_BAR; PG8_WAIT_L(0); PG8_MMA(0, 1, At, B1); PG8_BAR;
            PG8_LDA(At, 1, 1); PG8_STAGE(PG8_SA(1, 0), a3, voffA);
            PG8_BAR; PG8_WAIT_L(0); PG8_MMA(1, 0, At, B0); PG8_BAR; PG8_SCHED;
            PG8_STAGE(PG8_SB(1, 1), b3 + hstep, voffB);
            PG8_WAIT_V(6); PG8_BAR; PG8_MMA(1, 1, At, B1); PG8_BAR;
        }
        E(acc, cur, wr, wc, fr, fq);
        if (!has_next) break;
#pragma unroll
        for (int a = 0; a < 2; ++a)
#pragma unroll
            for (int b = 0; b < 2; ++b)
#pragma unroll
                for (int m = 0; m < 4; ++m)
#pragma unroll
                    for (int n = 0; n < 2; ++n) acc[a][b][m][n] = (f32x4){0.f, 0.f, 0.f, 0.f};
        cur = nxt; cA = nA; cB = nB; ++ui;
    }
    PG8_WAIT_V(0);
    if (wr == 0) PG8_BAR;
    PG8_BAR;
#undef PG8_SA
#undef PG8_SB
#undef PG8_STAGE
#undef PG8_LDA
#undef PG8_LDB
#undef PG8_MMA
#undef PG8_WAIT_V
#undef PG8_WAIT_L
#undef PG8_BAR
#undef PG8_SCHED
}
}

typedef f32x4 AccT[2][2][4][2];
#define EPI_LOOP_BEGIN \
    _Pragma("unroll") for (int ai = 0; ai < 2; ++ai) _Pragma("unroll") for (int m = 0; m < 4; ++m) { \
        const int row = u.pm * 256 + ai * 128 + wr * 64 + m * 16 + fr; \
        _Pragma("unroll") for (int bj = 0; bj < 2; ++bj) { const int ct = bj * 128 + wc * 32 + 8 * fq;   \
            const f32x4 v0 = acc[ai][bj][m][0], v1 = acc[ai][bj][m][1];
#define EPI_LOOP_END } }

struct EpiProj {
    unsigned char* ws;
    __device__ __forceinline__ void operator()(const AccT& acc, const pg8::Unit& u, int wr, int wc, int fr, int fq) const {
        const int pn = u.pn; bf16_t* base; int ld, c0;
        if (pn < 8)       { base = (bf16_t*)(ws + WS_CB); ld = 2048; c0 = pn * 256; }
        else if (pn < 16) { base = (bf16_t*)(ws + WS_CC); ld = 2048; c0 = (pn - 8) * 256; }
        else if (pn < 24) { base = (bf16_t*)(ws + WS_CH); ld = 2048; c0 = (pn - 16) * 256; }
        else if (pn < 32) { base = (bf16_t*)(ws + WS_Q);  ld = 2048; c0 = (pn - 24) * 256; }
        else if (pn < 34) { base = (bf16_t*)(ws + WS_K);  ld = 512;  c0 = (pn - 32) * 256; }
        else if (pn < 36) { base = (bf16_t*)(ws + WS_V);  ld = 512;  c0 = (pn - 34) * 256; }
        else if (pn < 40) { base = (bf16_t*)(ws + WS_QI); ld = 1024; c0 = (pn - 36) * 256; }
        else if (pn < 48) { base = (bf16_t*)(ws + WS_GA); ld = 2048; c0 = (pn - 40) * 256; }
        else if (pn < 56) { base = (bf16_t*)(ws + WS_GB); ld = 2048; c0 = (pn - 48) * 256; }
        else              { base = (bf16_t*)(ws + WS_KW); ld = 256;  c0 = 0; }
        EPI_LOOP_BEGIN
            u32x4 w; w.x = cvt_pk_bf16(v0[0], v0[1]); w.y = cvt_pk_bf16(v0[2], v0[3]); w.z = cvt_pk_bf16(v1[0], v1[1]); w.w = cvt_pk_bf16(v1[2], v1[3]);
            *(u32x4*)(base + (size_t)row * ld + c0 + ct) = w;
        EPI_LOOP_END
    }
};
struct EpiUp {
    bf16_t* HA; bf16_t* HG;
    __device__ __forceinline__ void operator()(const AccT& acc, const pg8::Unit& u, int wr, int wc, int fr, int fq) const {
        bf16_t* base = (u.pn < 22) ? HA : HG; const int c0 = (u.pn < 22 ? u.pn : u.pn - 22) * 256;
        EPI_LOOP_BEGIN
            u32x4 w; w.x = cvt_pk_bf16(v0[0], v0[1]); w.y = cvt_pk_bf16(v0[2], v0[3]); w.z = cvt_pk_bf16(v1[0], v1[1]); w.w = cvt_pk_bf16(v1[2], v1[3]);
            *(u32x4*)(base + (size_t)row * DFF + c0 + ct) = w;
        EPI_LOOP_END
    }
};
struct EpiGate1 {
    const bf16_t* G; float* TMP;
    __device__ __forceinline__ void operator()(const AccT& acc, const pg8::Unit& u, int wr, int wc, int fr, int fq) const {
        EPI_LOOP_BEGIN
            const size_t off = (size_t)row * DM + u.pn * 256 + ct;
            const u32x4 g = *(const u32x4*)(G + off);
            f32x4 o0, o1;
            o0[0] = sigmoidf_(bflo(g.x)) * v0[0]; o0[1] = sigmoidf_(bfhi(g.x)) * v0[1]; o0[2] = sigmoidf_(bflo(g.y)) * v0[2]; o0[3] = sigmoidf_(bfhi(g.y)) * v0[3];
            o1[0] = sigmoidf_(bflo(g.z)) * v1[0]; o1[1] = sigmoidf_(bfhi(g.z)) * v1[1]; o1[2] = sigmoidf_(bflo(g.w)) * v1[2]; o1[3] = sigmoidf_(bfhi(g.w)) * v1[3];
            *(f32x4*)(TMP + off) = o0; *(f32x4*)(TMP + off + 4) = o1;
        EPI_LOOP_END
    }
};
struct EpiGate2 {
    const bf16_t* G; const float* TMP; bf16_t* OUT;
    __device__ __forceinline__ void operator()(const AccT& acc, const pg8::Unit& u, int wr, int wc, int fr, int fq) const {
        EPI_LOOP_BEGIN
            const size_t off = (size_t)row * DM + u.pn * 256 + ct;
            const u32x4 g = *(const u32x4*)(G + off);
            const f32x4 t0 = *(const f32x4*)(TMP + off), t1 = *(const f32x4*)(TMP + off + 4);
            f32x4 o0, o1;
            o0[0] = t0[0] + sigmoidf_(bflo(g.x)) * v0[0]; o0[1] = t0[1] + sigmoidf_(bfhi(g.x)) * v0[1]; o0[2] = t0[2] + sigmoidf_(bflo(g.y)) * v0[2]; o0[3] = t0[3] + sigmoidf_(bfhi(g.y)) * v0[3];
            o1[0] = t1[0] + sigmoidf_(bflo(g.z)) * v1[0]; o1[1] = t1[1] + sigmoidf_(bfhi(g.z)) * v1[1]; o1[2] = t1[2] + sigmoidf_(bflo(g.w)) * v1[2]; o1[3] = t1[3] + sigmoidf_(bfhi(g.w)) * v1[3];
            u32x4 w; w.x = cvt_pk_bf16(o0[0], o0[1]); w.y = cvt_pk_bf16(o0[2], o0[3]); w.z = cvt_pk_bf16(o1[0], o1[1]); w.w = cvt_pk_bf16(o1[2], o1[3]);
            *(u32x4*)(OUT + off) = w;
        EPI_LOOP_END
    }
};
struct EpiRes {
    const float* X; const float* gmod  ; float* Z;
    __device__ __forceinline__ void operator()(const AccT& acc, const pg8::Unit& u, int wr, int wc, int fr, int fq) const {
        const float* gm = gmod + (u.pm >= 16 ? NMOD : 0) + u.pn * 256;
        EPI_LOOP_BEGIN
            const size_t off = (size_t)row * DM + u.pn * 256 + ct;
            const f32x4 x0 = *(const f32x4*)(X + off), x1 = *(const f32x4*)(X + off + 4);
            const f32x4 g0 = *(const f32x4*)(gm + ct), g1 = *(const f32x4*)(gm + ct + 4);
            f32x4 o0, o1;
#pragma unroll
            for (int j = 0; j < 4; ++j) { o0[j] = ALPHA * x0[j] + (1.0f + g0[j]) * v0[j]; o1[j] = ALPHA * x1[j] + (1.0f + g1[j]) * v1[j]; }
            *(f32x4*)(Z + off) = o0; *(f32x4*)(Z + off + 4) = o1;
        EPI_LOOP_END
    }
};

template <bool WIN>
__device__ __forceinline__ void transpose_item(const float* W, int K, int N, int NP, bf16_t* WT, LAS unsigned* scr, int item, int lane) {
    const int nblk = NP / 64, kb = item / nblk, nb = item % nblk, k0 = 64 * kb, n0 = 64 * nb;
    const int cl = lane & 15, kr = lane >> 4;
    const int np = n0 + 4 * cl; int sc = np; bool valid = true;
    if (WIN) {
        if (np < 10240) sc = np;
        else if (np < 12288) sc = 10320 + (np - 10240);
        else if (np < 14336) sc = 12368 + (np - 12288);
        else if (np < 14416) sc = 10240 + (np - 14336);
        else { valid = false; sc = 0; }
    }
    const float* src = W + (size_t)(k0 + 2 * kr) * N + sc;
    f32x4 va[8], vb[8];
#pragma unroll
    for (int i = 0; i < 8; ++i) {
        va[i] = *(const f32x4*)(src + (size_t)(8 * i) * N); vb[i] = *(const f32x4*)(src + (size_t)(8 * i + 1) * N);
        if (WIN && !valid) { va[i] = (f32x4){0.f, 0.f, 0.f, 0.f}; vb[i] = va[i]; } }
#pragma unroll
    for (int i = 0; i < 8; ++i)
#pragma unroll
        for (int j = 0; j < 4; ++j) scr[(4 * i + kr) * 65 + 4 * cl + j] = cvt_pk_bf16(va[i][j], vb[i][j]);
    asm volatile("s_waitcnt lgkmcnt(0)" ::: "memory");
    const int c = lane & 7;
#pragma unroll
    for (int j = 0; j < 8; ++j) { const int n = (lane >> 3) + 8 * j; const LAS unsigned* s = scr + (4 * c) * 65 + n;
        u32x4 o; o.x = s[0]; o.y = s[65]; o.z = s[130]; o.w = s[195];
        *(u32x4*)(WT + (size_t)(n0 + n) * K + k0 + 8 * c) = o; }
    asm volatile("s_waitcnt lgkmcnt(0)" ::: "memory");
}
__device__ __forceinline__ void transpose_rest(const float* w_a, const float* w_b, const float* w_o, const float* w_up, const float* w_down,
                                               bf16_t* WA_T, bf16_t* WB_T, bf16_t* WO_T, bf16_t* WUP_T, bf16_t* WD_T, LAS unsigned* scr, int w, int nw, int lane) {
    constexpr int I_SQ = 32 * 32, I_UP = 32 * 176, I_DN = 88 * 32;
    for (int it = w; it < 3 * I_SQ + I_UP + I_DN; it += nw) {
        int r = it;
        if (r < I_SQ) { transpose_item<false>(w_a, DM, DM, DM, WA_T, scr, r, lane); continue; } r -= I_SQ;
        if (r < I_SQ) { transpose_item<false>(w_b, DM, DM, DM, WB_T, scr, r, lane); continue; } r -= I_SQ;
        if (r < I_SQ) { transpose_item<false>(w_o, DM, DM, DM, WO_T, scr, r, lane); continue; } r -= I_SQ;
        if (r < I_UP) { transpose_item<false>(w_up, DM, 2 * DFF, 2 * DFF, WUP_T, scr, r, lane); continue; } r -= I_UP;
        transpose_item<false>(w_down, DFF, DM, DM, WD_T, scr, r, lane);
    }
}

#define XB_TMO      128
#define XB_XCNT(j)  (256  + 64 * (j))
#define XB_XSUB(j)  (1280 + 64 * (j))
#define XB_XGEN(j)  (2304 + 64 * (j))
#define XB_TOP      3328
#define XB_TOPGEN   3392
#define XCD_BAR_WORDS 3456
#define XB_SPIN_CAP (1u << 20)
__device__ __forceinline__ unsigned xb_ld(unsigned* p)              { return __hip_atomic_load(p, __ATOMIC_RELAXED, __HIP_MEMORY_SCOPE_AGENT); }
__device__ __forceinline__ unsigned xb_add(unsigned* p, unsigned v) { return __hip_atomic_fetch_add(p, v, __ATOMIC_RELAXED, __HIP_MEMORY_SCOPE_AGENT); }
__device__ __forceinline__ unsigned xb_xcc_id() { return (unsigned)__builtin_amdgcn_s_getreg((3 << 11) | 20) & 0xFu; }
#define XB_SPIN(cond, bar) do { unsigned _sp = 0; while (cond) { __builtin_amdgcn_s_sleep(1); \
    if ((++_sp & 255u) == 0u) { if (xb_ld(&(bar)[XB_TMO])) break; if (_sp > XB_SPIN_CAP) { atomicAdd(&(bar)[XB_TMO], 1u); break; } } } } while (0)
struct XcdBarrier { unsigned* bar; unsigned x; volatile LAS unsigned* st; };
__device__ __forceinline__ XcdBarrier xcd_barrier_post(unsigned* bar, volatile LAS unsigned* st) {
    XcdBarrier b; b.bar = bar; b.x = xb_xcc_id(); b.st = st;
    if (threadIdx.x == 0) (void)xb_add(&bar[XB_XCNT(b.x)], 1u);
    return b;
}
__device__ __forceinline__ void xcd_barrier_complete(unsigned* bar, unsigned x, unsigned& nloc, unsigned& nx) {
    const unsigned G = gridDim.x * gridDim.y * gridDim.z;
    unsigned sum, cnt, mine, sp = 0u;
    for (;;) {
        sum = 0u; cnt = 0u; mine = 0u;
#pragma unroll
        for (unsigned j = 0; j < 16; ++j) { const unsigned c = xb_ld(&bar[XB_XCNT(j)]); sum += c; cnt += (c > 0u) ? 1u : 0u; mine = (j == x) ? c : mine; }
        if (sum == G) break;
        __builtin_amdgcn_s_sleep(1);
        if ((++sp & 255u) == 0u) { if (xb_ld(&bar[XB_TMO])) break; if (sp > XB_SPIN_CAP) { atomicAdd(&bar[XB_TMO], 1u); break; } }
    }
    nloc = mine > 0u ? mine : 1u; nx = cnt > 0u ? cnt : 1u;
}
__device__ __forceinline__ void xcd_barrier(const XcdBarrier& b) {
    asm volatile("s_waitcnt vmcnt(0)" ::: "memory");
    __syncthreads();
    if (threadIdx.x == 0) {
        unsigned* bar = b.bar;
        __builtin_amdgcn_s_waitcnt(0);
        unsigned nloc = b.st[0], nx = b.st[1];
        if (nloc == 0u) { xcd_barrier_complete(bar, b.x, nloc, nx); b.st[0] = nloc; b.st[1] = nx; }
        const unsigned old = xb_add(&bar[XB_XSUB(b.x)], 1u);
        const unsigned gen = old / nloc;
        if (old + 1u == (gen + 1u) * nloc) {
            __builtin_amdgcn_fence(__ATOMIC_RELEASE, "agent");
            asm volatile("s_waitcnt vmcnt(0)" ::: "memory");
            const unsigned og = xb_add(&bar[XB_TOP], 1u);
            const unsigned tg = og / nx;
            if (og + 1u == (tg + 1u) * nx) xb_add(&bar[XB_TOPGEN], 1u);
            else XB_SPIN(xb_ld(&bar[XB_TOPGEN]) == tg, bar);
            __builtin_amdgcn_fence(__ATOMIC_ACQUIRE, "agent");
            xb_add(&bar[XB_XGEN(b.x)], 1u);
            asm volatile("s_waitcnt vmcnt(0)" ::: "memory");
        } else {
            XB_SPIN(xb_ld(&bar[XB_XGEN(b.x)]) == gen, bar);
            __builtin_amdgcn_fence(__ATOMIC_ACQUIRE, "agent");
            asm volatile("s_waitcnt vmcnt(0)" ::: "memory");
        }
    }
    __syncthreads();
}

struct Args { const float* in[18]; float* out; unsigned char* ws; };

__global__ void __launch_bounds__(NTHR, 2) fwd_megakernel(Args args) {
    extern __shared__ __attribute__((aligned(16))) unsigned char lds_raw[];
    LAS unsigned char* lds = (LAS unsigned char*)lds_raw;
    cg::grid_group grid = cg::this_grid();
    const int tid = threadIdx.x, lane = tid & 63, wave = __builtin_amdgcn_readfirstlane(tid >> 6);
    const int G = gridDim.x, bx = blockIdx.x;
    const int vcu = (G % 8 == 0) ? (bx % 8) * (G / 8) + bx / 8 : bx;
    const int gw = vcu * NWAVES + wave, NGW = G * NWAVES;
    const int gtid = vcu * NTHR + tid, NGT = G * NTHR;

    const float* x = args.in[0]; const float* cvec = args.in[1]; const float* w_cond = args.in[2]; const float* b_cond = args.in[3];
    const float* w_in = args.in[4]; const float* conv_a = args.in[5]; const float* kn_g = args.in[6]; const float* kn_b = args.in[7];
    const float* w_a = args.in[8]; const float* w_b = args.in[9]; const float* w_o = args.in[10]; const float* ln1_g = args.in[11]; const float* ln1_b = args.in[12];
    const float* w_up = args.in[13]; const float* conv_f = args.in[14]; const float* w_down = args.in[15]; const float* ln2_g = args.in[16]; const float* ln2_b = args.in[17];
    float* out = args.out; unsigned char* ws = args.ws;
    float* PART = (float*)(ws + WS_PART); float* MOD = (float*)(ws + WS_MOD);
    bf16_t* WIN_T = (bf16_t*)(ws + WS_WIN); bf16_t* WA_T = (bf16_t*)(ws + WS_WA); bf16_t* WB_T = (bf16_t*)(ws + WS_WB); bf16_t* WO_T = (bf16_t*)(ws + WS_WO);
    bf16_t* WUP_T = (bf16_t*)(ws + WS_WUP); bf16_t* WD_T = (bf16_t*)(ws + WS_WD);
    bf16_t* U = (bf16_t*)(ws + WS_U);
    bf16_t* CB = (bf16_t*)(ws + WS_CB); bf16_t* CC = (bf16_t*)(ws + WS_CC); bf16_t* CH = (bf16_t*)(ws + WS_CH); bf16_t* Q = (bf16_t*)(ws + WS_Q);
    bf16_t* GA = (bf16_t*)(ws + WS_GA); bf16_t* GB = (bf16_t*)(ws + WS_GB); bf16_t* KB = (bf16_t*)(ws + WS_K); bf16_t* VB = (bf16_t*)(ws + WS_V);
    bf16_t* VT = (bf16_t*)(ws + WS_VT); bf16_t* QI = (bf16_t*)(ws + WS_QI); bf16_t* KW = (bf16_t*)(ws + WS_KW); bf16_t* KIB = (bf16_t*)(ws + WS_KIB);
    float* WIF = (float*)(ws + WS_WIF); unsigned long long* MASK = (unsigned long long*)(ws + WS_MASK);
    float* Z = (float*)(ws + WS_Z); float* Z2 = (float*)(ws + WS_Z2); bf16_t* HA = (bf16_t*)(ws + WS_HA); bf16_t* HG = (bf16_t*)(ws + WS_HG);
    float* X1 = out; float* TMP = out;
    unsigned* BARW = (unsigned*)ws;
    volatile LAS unsigned* bst = (volatile LAS unsigned*)(lds + 131072);
    if (tid < 2) bst[tid] = 0u;
    if (bx == 0) for (int i = tid; i < XCD_BAR_WORDS; i += NTHR) __hip_atomic_store(BARW + i, 0u, __ATOMIC_RELAXED, __HIP_MEMORY_SCOPE_AGENT);

    for (int rep_ = 0; rep_ < REP_P0; ++rep_) {
    {
        LAS float* cact = (LAS float*)lds;
        for (int i = tid; i < 2 * DM; i += NTHR) { const float c = cvec[i]; cact[i] = c / (1.0f + __expf(-c)); }
        __syncthreads();
        for (int item = gw; item < 8 * 192; item += NGW) {
            const int kc = item / 192, cb = item % 192, col = cb * 64 + (lane & 15) * 4, kq = lane >> 4;
            f32x4 a0 = {0.f, 0.f, 0.f, 0.f}, a1 = {0.f, 0.f, 0.f, 0.f};
            const float* wp = w_cond + (size_t)(kc * 256 + kq) * NMOD + col;
#pragma unroll 8
            for (int i = 0; i < 64; ++i) { const f32x4 w = *(const f32x4*)(wp + (size_t)(4 * i) * NMOD); const int k = kc * 256 + kq + 4 * i;
                const float s0 = cact[k], s1 = cact[DM + k]; a0 += s0 * w; a1 += s1 * w; }
#pragma unroll
            for (int j = 0; j < 4; ++j) { a0[j] += __shfl_xor(a0[j], 16); a0[j] += __shfl_xor(a0[j], 32); a1[j] += __shfl_xor(a1[j], 16); a1[j] += __shfl_xor(a1[j], 32); }
            if (lane < 16) { *(f32x4*)(PART + (size_t)(kc * 2 + 0) * NMOD + col) = a0; *(f32x4*)(PART + (size_t)(kc * 2 + 1) * NMOD + col) = a1; }
        }
        LAS unsigned* scr = (LAS unsigned*)(lds + 16384 + wave * 8448);
        for (int it = gw; it < 32 * (NPROJ / 64); it += NGW) transpose_item<true>(w_in, DM, 14416, NPROJ, WIN_T, scr, it, lane);
    }
    __syncthreads();
    }
    grid.sync();
    const XcdBarrier xbar = xcd_barrier_post(BARW, bst);

    for (int rep_ = 0; rep_ < REP_P1; ++rep_) {
    {
        for (int idx = gtid; idx < 2 * NMOD; idx += NGT) { const int b = idx / NMOD, e = idx % NMOD; float s = b_cond[e];
#pragma unroll
            for (int kc = 0; kc < 8; ++kc) s += PART[(size_t)(kc * 2 + b) * NMOD + e];
            MOD[idx] = s; }
        for (int rb = vcu; rb < MT / 32; rb += G) {
            const int b = rb >> 7, col = (tid & 255) * 8, r0 = rb * 32 + (tid >> 8) * 16;
            f32x4 sh0 = *(const f32x4*)(b_cond + col), sh1 = *(const f32x4*)(b_cond + col + 4), sc0 = *(const f32x4*)(b_cond + DM + col), sc1 = *(const f32x4*)(b_cond + DM + col + 4);
#pragma unroll
            for (int kc = 0; kc < 8; ++kc) { const float* p = PART + (size_t)(kc * 2 + b) * NMOD + col;
                sh0 += *(const f32x4*)(p); sh1 += *(const f32x4*)(p + 4); sc0 += *(const f32x4*)(p + DM); sc1 += *(const f32x4*)(p + DM + 4); }
#pragma unroll 4
            for (int r = 0; r < 16; ++r) { const size_t off = (size_t)(r0 + r) * DM + col;
                const f32x4 x0 = *(const f32x4*)(x + off), x1 = *(const f32x4*)(x + off + 4);
                f32x4 u0, u1;
#pragma unroll
                for (int j = 0; j < 4; ++j) { u0[j] = x0[j] * (1.0f + sc0[j]) + sh0[j]; u1[j] = x1[j] * (1.0f + sc1[j]) + sh1[j]; }
                u32x4 w; w.x = cvt_pk_bf16(u0[0], u0[1]); w.y = cvt_pk_bf16(u0[2], u0[3]); w.z = cvt_pk_bf16(u1[0], u1[1]); w.w = cvt_pk_bf16(u1[2], u1[3]);
                *(u32x4*)(U + off) = w; }
        }
    }
    xcd_barrier(xbar);
    }

    {
        pg8::Gemm g{U, WIN_T, MT, NPROJ, DM}; pg8::StaticOrder S; S.init(MT, NPROJ, G, bx);
        { pg8::Unit tu; const int nfull = (MT / 256) * (NPROJ / 256) - 7 * G;
          if (nfull > 0 && nfull < G && !S.next(7, tu)) { LAS unsigned* scr = (LAS unsigned*)(lds + wave * 8448);
              transpose_rest(w_a, w_b, w_o, w_up, w_down, WA_T, WB_T, WO_T, WUP_T, WD_T, scr, (bx - nfull) * NWAVES + wave, (G - nfull) * NWAVES, lane); }
          else if (!(nfull > 0 && nfull < G)) { LAS unsigned* scr = (LAS unsigned*)(lds + wave * 8448);
              transpose_rest(w_a, w_b, w_o, w_up, w_down, WA_T, WB_T, WO_T, WUP_T, WD_T, scr, gw, NGW, lane); } }
        __syncthreads();
        EpiProj E{ws};
        pg8::gemm_phase<EpiProj>(lds, g, S, E);
    }
    xcd_barrier(xbar);

    {
        for (int un = gtid; un < (MT / 16) * 256; un += NGT) {
            const int cg8 = un & 255, rb = un >> 8, col = cg8 * 8, m0 = rb * 16, t0 = m0 & (SEQ - 1);
            float w0[8], w1[8], w2[8], p1[8], p2[8];
#pragma unroll
            for (int j = 0; j < 8; ++j) { w0[j] = conv_a[col + j]; w1[j] = conv_a[DM + col + j]; w2[j] = conv_a[2 * DM + col + j]; p1[j] = 0.f; p2[j] = 0.f; }
            if (t0 != 0) {
                const u32x4 c2 = *(const u32x4*)(CC + (size_t)(m0 - 2) * DM + col), h2 = *(const u32x4*)(CH + (size_t)(m0 - 2) * DM + col);
                const u32x4 c1 = *(const u32x4*)(CC + (size_t)(m0 - 1) * DM + col), h1 = *(const u32x4*)(CH + (size_t)(m0 - 1) * DM + col);
#pragma unroll
                for (int j = 0; j < 4; ++j) { p2[2 * j] = bflo(c2[j]) * bflo(h2[j]); p2[2 * j + 1] = bfhi(c2[j]) * bfhi(h2[j]); p1[2 * j] = bflo(c1[j]) * bflo(h1[j]); p1[2 * j + 1] = bfhi(c1[j]) * bfhi(h1[j]); }
            }
#pragma unroll 4
            for (int r = 0; r < 16; ++r) { const size_t off = (size_t)(m0 + r) * DM + col;
                const u32x4 cc = *(const u32x4*)(CC + off), ch = *(const u32x4*)(CH + off), cb = *(const u32x4*)(CB + off);
                float p0[8], y[8];
#pragma unroll
                for (int j = 0; j < 4; ++j) { p0[2 * j] = bflo(cc[j]) * bflo(ch[j]); p0[2 * j + 1] = bfhi(cc[j]) * bfhi(ch[j]); }
#pragma unroll
                for (int j = 0; j < 8; ++j) { const float cv = w0[j] * p2[j] + w1[j] * p1[j] + w2[j] * p0[j]; const float cbv = (j & 1) ? bfhi(cb[j >> 1]) : bflo(cb[j >> 1]); y[j] = cbv * cv; p2[j] = p1[j]; p1[j] = p0[j]; }
                u32x4 w; w.x = cvt_pk_bf16(y[0], y[1]); w.y = cvt_pk_bf16(y[2], y[3]); w.z = cvt_pk_bf16(y[4], y[5]); w.w = cvt_pk_bf16(y[6], y[7]);
                *(u32x4*)(CB + off) = w; }
        }
        for (int un = vcu; un < NB * 4 * 64; un += G) {
            const int sb = un & 63, n = (un >> 6) & 3, b = un >> 8;
            LAS unsigned short* tl = (LAS unsigned short*)lds;
            __syncthreads();
#pragma unroll
            for (int j = 0; j < 2; ++j) { const int q = tid + 512 * j, row = q >> 4, ch = q & 15;
                const u32x4 v = *(const u32x4*)(VB + (size_t)(b * SEQ + sb * 64 + row) * 512 + n * 128 + ch * 8);
                LAS unsigned* d = (LAS unsigned*)(tl + row * 130 + ch * 8); d[0] = v.x; d[1] = v.y; d[2] = v.z; d[3] = v.w; }
            __syncthreads();
#pragma unroll
            for (int j = 0; j < 2; ++j) { const int q = tid + 512 * j, s8 = q & 7, d = q >> 3;
                unsigned e[8];
#pragma unroll
                for (int k = 0; k < 8; ++k) e[k] = tl[(s8 * 8 + k) * 130 + d];
                u32x4 w; w.x = e[0] | (e[1] << 16); w.y = e[2] | (e[3] << 16); w.z = e[4] | (e[5] << 16); w.w = e[6] | (e[7] << 16);
                *(u32x4*)(VT + ((size_t)((b * 4 + n) * 128 + d)) * SEQ + sb * 64 + s8 * 8) = w; }
        }
        __syncthreads();
        for (int m = gtid; m < MT; m += NGT) {
            float v[64]; float s = 0.f;
#pragma unroll
            for (int j = 0; j < 8; ++j) { const u32x4 w = *(const u32x4*)(KW + (size_t)m * 256 + j * 8);
#pragma unroll
                for (int k = 0; k < 4; ++k) { v[j * 8 + 2 * k] = bflo(w[k]); v[j * 8 + 2 * k + 1] = bfhi(w[k]); } }
#pragma unroll
            for (int j = 0; j < 64; ++j) s += v[j];
            const float mu = s * (1.0f / 64.0f); float s2 = 0.f;
#pragma unroll
            for (int j = 0; j < 64; ++j) { v[j] -= mu; s2 += v[j] * v[j]; }
            const float rstd = rsqrtf(s2 * (1.0f / 64.0f) + LN_EPS);
#pragma unroll
            for (int j = 0; j < 8; ++j) { u32x4 w;
#pragma unroll
                for (int k = 0; k < 4; ++k) { const int e = j * 8 + 2 * k; w[k] = cvt_pk_bf16(v[e] * rstd * kn_g[e] + kn_b[e], v[e + 1] * rstd * kn_g[e + 1] + kn_b[e + 1]); }
                *(u32x4*)(KIB + (size_t)m * 64 + j * 8) = w; }
#pragma unroll
            for (int j = 0; j < 2; ++j) { const u32x4 w = *(const u32x4*)(KW + (size_t)m * 256 + 64 + j * 8);
                f32x4 a, b2; a[0] = bflo(w.x); a[1] = bfhi(w.x); a[2] = bflo(w.y); a[3] = bfhi(w.y); b2[0] = bflo(w.z); b2[1] = bfhi(w.z); b2[2] = bflo(w.w); b2[3] = bfhi(w.w);
                *(f32x4*)(WIF + (size_t)m * 16 + j * 8) = a; *(f32x4*)(WIF + (size_t)m * 16 + j * 8 + 4) = b2; }
        }
    }
    xcd_barrier(xbar);

    for (int rep_ = 0; rep_ < REP_P4; ++rep_) {
    for (int blk = vcu; blk < 256; blk += G) {
        const int c0 = blk >> 2, jt = (blk & 3) * 8 + wave;
        for (int r = 0; r < 4; ++r) {
            const int b = r & 1, hh = r >> 1, tok = jt + 32 * hh, c = hh ? 63 - c0 : c0;
            const int m = b * SEQ + 64 * c + tok, nblk = c + 1, ntile = (nblk + 3) >> 2;
            const int kk = lane & 15, quad = lane >> 4;
            const bf16_t* qp = QI + (size_t)m * 1024 + kk * 64 + quad * 8;
            const bf16x8 a0 = *(const bf16x8*)(qp), a1 = *(const bf16x8*)(qp + 32);
            const f32x4 w4 = *(const f32x4*)(WIF + (size_t)m * 16 + quad * 4);
            const bool b0 = (lane & 16) != 0, b1 = (lane & 32) != 0;
            unsigned sc[64];
            const bf16_t* ksrc = KIB + (size_t)(b * SEQ) * 64 + (size_t)tid * 8;
            int kdst[4];
#pragma unroll
            for (int j = 0; j < 4; ++j) { const int q = tid + 512 * j, key = q >> 3, ch = q & 7; kdst[j] = key * 128 + ((ch ^ (key & 7)) << 4); }
            const int rd0 = kk * 128 + (((quad) ^ (kk & 7)) << 4), rd1 = kk * 128 + (((quad + 4) ^ (kk & 7)) << 4);
            u32x4 pf[4];
#pragma unroll
            for (int j = 0; j < 4; ++j) pf[j] = *(const u32x4*)(ksrc + (size_t)j * 4096);
#pragma unroll
            for (int j = 0; j < 4; ++j) *(LAS u32x4*)(lds + kdst[j]) = pf[j];
            __syncthreads();
#pragma unroll
            for (int tile = 0; tile < 16; ++tile) {
                if (tile < ntile) {
                    const int buf = (tile & 1) * 32768;
                    const bool more = (tile + 1 < ntile);
                    if (more) {
#pragma unroll
                        for (int j = 0; j < 4; ++j) pf[j] = *(const u32x4*)(ksrc + (size_t)(tile + 1) * 16384 + (size_t)j * 4096); }
#pragma unroll
                    for (int ii = 0; ii < 4; ++ii) {
                        const int i = 4 * tile + ii;
                        float v[4];
#pragma unroll
                        for (int g = 0; g < 4; ++g) {
                            const LAS unsigned char* kp = lds + buf + (64 * ii + 16 * g) * 128;
                            const bf16x8 k0 = *(const LAS bf16x8*)(kp + rd0), k1 = *(const LAS bf16x8*)(kp + rd1);
                            f32x4 acc = {0.f, 0.f, 0.f, 0.f};
                            acc = __builtin_amdgcn_mfma_f32_16x16x32_bf16(a0, k0, acc, 0, 0, 0);
                            acc = __builtin_amdgcn_mfma_f32_16x16x32_bf16(a1, k1, acc, 0, 0, 0);
                            v[g] = w4[0] * fmaxf(acc[0], 0.f) + w4[1] * fmaxf(acc[1], 0.f) + w4[2] * fmaxf(acc[2], 0.f) + w4[3] * fmaxf(acc[3], 0.f);
                        }
                        const float s0 = b0 ? v[0] : v[1], s1 = b0 ? v[2] : v[3];
                        const float r0 = __shfl_xor(s0, 16), r1 = __shfl_xor(s1, 16);
                        const float t0 = (b0 ? v[1] : v[0]) + r0, t1 = (b0 ? v[3] : v[2]) + r1;
                        const float s2 = b1 ? t0 : t1;
                        const float r2 = __shfl_xor(s2, 32);
                        const float fin = (b1 ? t1 : t0) + r2;
                        const unsigned ub = __float_as_uint(fin);
                        const unsigned key = (ub & 0x80000000u) ? ~ub : (ub | 0x80000000u);
                        sc[i] = (i < nblk) ? key : 0u;
                    }
                    if (more) { const int nb2 = ((tile + 1) & 1) * 32768;
#pragma unroll
                        for (int j = 0; j < 4; ++j) *(LAS u32x4*)(lds + nb2 + kdst[j]) = pf[j]; }
                    __syncthreads();
                } else {
#pragma unroll
                    for (int ii = 0; ii < 4; ++ii) sc[4 * tile + ii] = 0u;
                }
            }
            unsigned long long myword = 0ull;
            if (nblk <= 4) {
                if (lane < nblk) myword = ~0ull;
            } else {
                unsigned T = 0u;
                for (int bit = 31; bit >= 0; --bit) {
                    const unsigned cand = T | (1u << bit);
                    int cnt = 0;
#pragma unroll
                    for (int g8 = 0; g8 < 8; ++g8) {
                        if (g8 * 8 < nblk) {
#pragma unroll
                            for (int e = 0; e < 8; ++e) cnt += __popcll(__ballot(sc[g8 * 8 + e] >= cand));
                        }
                    }
                    if (cnt >= 256) T = cand;
                }
                int cgt = 0;
#pragma unroll
                for (int i = 0; i < 64; ++i) cgt += __popcll(__ballot(sc[i] > T));
                int need = 256 - cgt;
#pragma unroll
                for (int i = 0; i < 64; ++i) {
                    if (i < nblk) {
                        const unsigned long long gt = __ballot(sc[i] > T), eq = __ballot(sc[i] == T);
                        unsigned long long sel = 0ull;
                        if (eq != 0ull && need > 0) {
                            const int ne = __popcll(eq);
                            if (ne <= need) { sel = eq; need -= ne; }
                            else { unsigned long long tmp = eq; for (int k = 0; k < need; ++k) { const unsigned long long low = tmp & (0ull - tmp); sel |= low; tmp ^= low; } need = 0; }
                        }
                        const unsigned long long word = gt | sel;
                        if (lane == i) myword = word;
                    }
                }
            }
            MASK[(size_t)m * 64 + lane] = myword;
        }
    }
    xcd_barrier(xbar);
    }

    for (int rep_ = 0; rep_ < REP_P5; ++rep_) {
    for (int it0 = vcu; it0 < 256; it0 += G) {
        const int cc0 = it0 & 31, n = (it0 >> 5) & 3, b = it0 >> 7;
        for (int half = 0; half < 2; ++half) {
            const int c = half ? 63 - cc0 : cc0, nblk = c + 1;
            const int h = lane >> 5, r = lane & 31;
            const int hq = 4 * n + (wave >> 1), th = wave & 1;
            const int mq = b * SEQ + 64 * c + 32 * th + r;
            bf16x8 qf[8];
            { const bf16_t* qp = Q + (size_t)mq * DM + hq * 128 + 8 * h;
#pragma unroll
              for (int ks = 0; ks < 8; ++ks) qf[ks] = *(const bf16x8*)(qp + ks * 16); }
            f32x16 o[4];
#pragma unroll
            for (int dt = 0; dt < 4; ++dt)
#pragma unroll
                for (int i = 0; i < 16; ++i) o[dt][i] = 0.f;
            float mrun = -INFINITY, lrun = 0.f;
            const int kq0 = tid, kq1 = tid + 512;
            const bf16_t* ksrc0 = KB + (size_t)(b * SEQ + (kq0 >> 4)) * 512 + n * 128 + (kq0 & 15) * 8;
            const bf16_t* ksrc1 = KB + (size_t)(b * SEQ + (kq1 >> 4)) * 512 + n * 128 + (kq1 & 15) * 8;
            const int kd0 = (kq0 >> 4) * 272 + (kq0 & 15) * 16, kd1 = (kq1 >> 4) * 272 + (kq1 & 15) * 16;
            const bf16_t* vsrc0 = VT + ((size_t)((b * 4 + n) * 128 + (kq0 >> 3))) * SEQ + (kq0 & 7) * 8;
            const bf16_t* vsrc1 = VT + ((size_t)((b * 4 + n) * 128 + (kq1 >> 3))) * SEQ + (kq1 & 7) * 8;
            const int vd0 = 17408 + (kq0 >> 3) * 136 + (kq0 & 7) * 16, vd1 = 17408 + (kq1 >> 3) * 136 + (kq1 & 7) * 16;
            u32x4 pk0, pk1, pv0, pv1;
            pk0 = *(const u32x4*)(ksrc0); pk1 = *(const u32x4*)(ksrc1); pv0 = *(const u32x4*)(vsrc0); pv1 = *(const u32x4*)(vsrc1);
            {
                *(LAS u32x4*)(lds + kd0) = pk0; *(LAS u32x4*)(lds + kd1) = pk1;
                *(LAS u32x2*)(lds + vd0) = (u32x2){pv0.x, pv0.y}; *(LAS u32x2*)(lds + vd0 + 8) = (u32x2){pv0.z, pv0.w};
                *(LAS u32x2*)(lds + vd1) = (u32x2){pv1.x, pv1.y}; *(LAS u32x2*)(lds + vd1 + 8) = (u32x2){pv1.z, pv1.w};
            }
            __syncthreads();
            const unsigned long long* mrow = MASK + (size_t)mq * 64;
            for (int kt = 0; kt < nblk; ++kt) {
                const int buf = (kt & 1) * 34816;
                const bool more = (kt + 1 < nblk);
                if (more) { const size_t ko = (size_t)(kt + 1) * 64 * 512, vo = (size_t)(kt + 1) * 64;
                    pk0 = *(const u32x4*)(ksrc0 + ko); pk1 = *(const u32x4*)(ksrc1 + ko); pv0 = *(const u32x4*)(vsrc0 + vo); pv1 = *(const u32x4*)(vsrc1 + vo); }
                const unsigned long long mw = mrow[kt];
                f32x16 st[2];
#pragma unroll
                for (int sub = 0; sub < 2; ++sub) {
#pragma unroll
                    for (int i = 0; i < 16; ++i) st[sub][i] = 0.f;
                    const LAS unsigned char* kb = lds + buf + (32 * sub + r) * 272 + h * 16;
#pragma unroll
                    for (int ks = 0; ks < 8; ++ks) { const bf16x8 kf = *(const LAS bf16x8*)(kb + ks * 32);
                        st[sub] = __builtin_amdgcn_mfma_f32_32x32x16_bf16(kf, qf[ks], st[sub], 0, 0, 0); }
                }
                constexpr float CSC = 0.08838834764831845f * 1.4426950408889634f;
                float mx = -INFINITY;
#pragma unroll
                for (int sub = 0; sub < 2; ++sub) { const unsigned w = (unsigned)(sub ? (mw >> 32) : (mw & 0xffffffffull)) >> (4 * h);
#pragma unroll
                    for (int i = 0; i < 16; ++i) { const int pos = (i & 3) + 8 * (i >> 2);
                        const float sv = ((w >> pos) & 1u) ? st[sub][i] * CSC : -INFINITY; st[sub][i] = sv; mx = fmaxf(mx, sv); } }
                mx = fmaxf(mx, __shfl_xor(mx, 32));
                const float mnew = fmaxf(mrun, mx), msafe = (mnew == -INFINITY) ? 0.f : mnew;
                const float alpha = __builtin_amdgcn_exp2f(mrun - msafe);
                float ls = 0.f;
#pragma unroll
                for (int sub = 0; sub < 2; ++sub)
#pragma unroll
                    for (int i = 0; i < 16; ++i) { const float p = __builtin_amdgcn_exp2f(st[sub][i] - msafe); st[sub][i] = p; ls += p; }
                lrun = lrun * alpha + ls; mrun = mnew;
#pragma unroll
                for (int dt = 0; dt < 4; ++dt)
#pragma unroll
                    for (int i = 0; i < 16; ++i) o[dt][i] *= alpha;
#pragma unroll
                for (int sub = 0; sub < 2; ++sub)
#pragma unroll
                    for (int s = 0; s < 2; ++s) {
                        u32x4 pw; pw.x = cvt_pk_bf16(st[sub][8 * s + 0], st[sub][8 * s + 1]); pw.y = cvt_pk_bf16(st[sub][8 * s + 2], st[sub][8 * s + 3]);
                        pw.z = cvt_pk_bf16(st[sub][8 * s + 4], st[sub][8 * s + 5]); pw.w = cvt_pk_bf16(st[sub][8 * s + 6], st[sub][8 * s + 7]);
                        const bf16x8 pf = __builtin_bit_cast(bf16x8, pw);
#pragma unroll
                        for (int dt = 0; dt < 4; ++dt) {
                            const LAS unsigned char* vp = lds + buf + 17408 + (32 * dt + r) * 136 + (32 * sub + 16 * s + 4 * h) * 2;
                            const u32x2 lo = *(const LAS u32x2*)(vp), hi = *(const LAS u32x2*)(vp + 16);
                            const u32x4 vw = {lo.x, lo.y, hi.x, hi.y};
                            o[dt] = __builtin_amdgcn_mfma_f32_32x32x16_bf16(__builtin_bit_cast(bf16x8, vw), pf, o[dt], 0, 0, 0);
                        }
                    }
                if (more) { const int nb2 = ((kt + 1) & 1) * 34816;
                    *(LAS u32x4*)(lds + nb2 + kd0) = pk0; *(LAS u32x4*)(lds + nb2 + kd1) = pk1;
                    *(LAS u32x2*)(lds + nb2 + vd0) = (u32x2){pv0.x, pv0.y}; *(LAS u32x2*)(lds + nb2 + vd0 + 8) = (u32x2){pv0.z, pv0.w};
                    *(LAS u32x2*)(lds + nb2 + vd1) = (u32x2){pv1.x, pv1.y}; *(LAS u32x2*)(lds + nb2 + vd1 + 8) = (u32x2){pv1.z, pv1.w}; }
                __syncthreads();
            }
            const float ltot = lrun + __shfl_xor(lrun, 32);
            const float inv = 1.0f / ltot;
            bf16_t* op = (rep_ + 1 < REP_P5 ? (bf16_t*)Z : Q) + (size_t)mq * DM + hq * 128 + 4 * h;
#pragma unroll
            for (int dt = 0; dt < 4; ++dt)
#pragma unroll
                for (int g4 = 0; g4 < 4; ++g4) {
                    u32x2 w; w.x = cvt_pk_bf16(o[dt][4 * g4 + 0] * inv, o[dt][4 * g4 + 1] * inv); w.y = cvt_pk_bf16(o[dt][4 * g4 + 2] * inv, o[dt][4 * g4 + 3] * inv);
                    *(u32x2*)(op + 32 * dt + 8 * g4) = w; }
        }
    }
    xcd_barrier(xbar);
    }

    {
        pg8::StaticOrder S; S.init(MT, DM, G, bx);
        { pg8::Gemm g{CB, WA_T, MT, DM, DM}; EpiGate1 E{GA, TMP}; pg8::gemm_phase<EpiGate1>(lds, g, S, E); }
        { pg8::Gemm g{Q, WB_T, MT, DM, DM}; EpiGate2 E{GB, TMP, U}; pg8::gemm_phase<EpiGate2>(lds, g, S, E); }
    }
    xcd_barrier(xbar);

    {
        pg8::Gemm g{U, WO_T, MT, DM, DM}; pg8::StaticOrder S; S.init(MT, DM, G, bx);
        EpiRes E{x, MOD + 2 * DM, Z};
        pg8::gemm_phase<EpiRes>(lds, g, S, E);
    }
    xcd_barrier(xbar);

    for (int m = gw; m < MT; m += NGW) {
        const int b = m >> 12;
        const float* zr = Z + (size_t)m * DM;
        f32x4 v[8]; float s = 0.f;
#pragma unroll
        for (int j = 0; j < 8; ++j) { v[j] = *(const f32x4*)(zr + j * 256 + lane * 4); s += (v[j][0] + v[j][1]) + (v[j][2] + v[j][3]); }
        const float mu = wave_sum(s) * (1.0f / DM); float s2 = 0.f;
#pragma unroll
        for (int j = 0; j < 8; ++j) { v[j] = v[j] - mu; s2 += (v[j][0] * v[j][0] + v[j][1] * v[j][1]) + (v[j][2] * v[j][2] + v[j][3] * v[j][3]); }
        const float rstd = rsqrtf(wave_sum(s2) * (1.0f / DM) + LN_EPS);
        const float* shf = MOD + (size_t)b * NMOD + 3 * DM; const float* scf = MOD + (size_t)b * NMOD + 4 * DM;
#pragma unroll
        for (int j = 0; j < 8; ++j) { const int col = j * 256 + lane * 4;
            const f32x4 gg = *(const f32x4*)(ln1_g + col), bb = *(const f32x4*)(ln1_b + col), sc4 = *(const f32x4*)(scf + col), sh4 = *(const f32x4*)(shf + col);
            f32x4 y, uu;
#pragma unroll
            for (int k = 0; k < 4; ++k) { y[k] = v[j][k] * rstd * gg[k] + bb[k]; uu[k] = y[k] * (1.0f + sc4[k]) + sh4[k]; }
            *(f32x4*)(X1 + (size_t)m * DM + col) = y;
            u32x2 w; w.x = cvt_pk_bf16(uu[0], uu[1]); w.y = cvt_pk_bf16(uu[2], uu[3]);
            *(u32x2*)(U + (size_t)m * DM + col) = w; }
    }
    xcd_barrier(xbar);

    {
        pg8::Gemm g{U, WUP_T, MT, 2 * DFF, DM}; pg8::StaticOrder S; S.init(MT, 2 * DFF, G, bx);
        EpiUp E{HA, HG};
        pg8::gemm_phase<EpiUp>(lds, g, S, E);
    }
    xcd_barrier(xbar);

    for (int un = gtid; un < (MT / 16) * (DFF / 8); un += NGT) {
        const int cg8 = un % (DFF / 8), rb = un / (DFF / 8), col = cg8 * 8, m0 = rb * 16, t0 = m0 & (SEQ - 1);
        float w0[8], w1[8], w2[8], p1[8], p2[8];
#pragma unroll
        for (int j = 0; j < 8; ++j) { w0[j] = conv_f[col + j]; w1[j] = conv_f[DFF + col + j]; w2[j] = conv_f[2 * DFF + col + j]; p1[j] = 0.f; p2[j] = 0.f; }
        if (t0 != 0) {
            const u32x4 a2 = *(const u32x4*)(HA + (size_t)(m0 - 2) * DFF + col), a1 = *(const u32x4*)(HA + (size_t)(m0 - 1) * DFF + col);
#pragma unroll
            for (int j = 0; j < 4; ++j) { p2[2 * j] = bflo(a2[j]); p2[2 * j + 1] = bfhi(a2[j]); p1[2 * j] = bflo(a1[j]); p1[2 * j + 1] = bfhi(a1[j]); }
        }
#pragma unroll 4
        for (int r = 0; r < 16; ++r) { const size_t off = (size_t)(m0 + r) * DFF + col;
            const u32x4 a = *(const u32x4*)(HA + off), gt = *(const u32x4*)(HG + off);
            float p0[8], y[8];
#pragma unroll
            for (int j = 0; j < 4; ++j) { p0[2 * j] = bflo(a[j]); p0[2 * j + 1] = bfhi(a[j]); }
#pragma unroll
            for (int j = 0; j < 8; ++j) { const float cv = w0[j] * p2[j] + w1[j] * p1[j] + w2[j] * p0[j];
                const float inner = 0.7978845608028654f * (cv + 0.044715f * cv * cv * cv);
                const float ge = cv * __builtin_amdgcn_rcpf(1.0f + __expf(-2.0f * inner));
                const float gv = (j & 1) ? bfhi(gt[j >> 1]) : bflo(gt[j >> 1]); y[j] = ge * gv; p2[j] = p1[j]; p1[j] = p0[j]; }
            u32x4 w; w.x = cvt_pk_bf16(y[0], y[1]); w.y = cvt_pk_bf16(y[2], y[3]); w.z = cvt_pk_bf16(y[4], y[5]); w.w = cvt_pk_bf16(y[6], y[7]);
            *(u32x4*)(HG + off) = w; }
    }
    xcd_barrier(xbar);

    {
        pg8::Gemm g{HG, WD_T, MT, DM, DFF}; pg8::StaticOrder S; S.init(MT, DM, G, bx);
        EpiRes E{X1, MOD + 5 * DM, Z2};
        pg8::gemm_phase<EpiRes>(lds, g, S, E);
    }
    xcd_barrier(xbar);

    for (int m = gw; m < MT; m += NGW) {
        const float* zr = Z2 + (size_t)m * DM;
        f32x4 v[8]; float s = 0.f;
#pragma unroll
        for (int j = 0; j < 8; ++j) { v[j] = *(const f32x4*)(zr + j * 256 + lane * 4); s += (v[j][0] + v[j][1]) + (v[j][2] + v[j][3]); }
        const float mu = wave_sum(s) * (1.0f / DM); float s2 = 0.f;
#pragma unroll
        for (int j = 0; j < 8; ++j) { v[j] = v[j] - mu; s2 += (v[j][0] * v[j][0] + v[j][1] * v[j][1]) + (v[j][2] * v[j][2] + v[j][3] * v[j][3]); }
        const float rstd = rsqrtf(wave_sum(s2) * (1.0f / DM) + LN_EPS);
#pragma unroll
        for (int j = 0; j < 8; ++j) { const int col = j * 256 + lane * 4;
            const f32x4 gg = *(const f32x4*)(ln2_g + col), bb = *(const f32x4*)(ln2_b + col);
            f32x4 y;
#pragma unroll
            for (int k = 0; k < 4; ++k) y[k] = v[j][k] * rstd * gg[k] + bb[k];
            *(f32x4*)(out + (size_t)m * DM + col) = y; }
    }
}

extern "C" void kernel_launch(void* const* d_in, const int* in_sizes, int n_in, void* d_out, int out_size, void* d_ws, size_t ws_size, hipStream_t stream) {
    static int grid_blocks = 0;
    if (grid_blocks == 0) {
        if (n_in != 18 || ws_size < WS_END) { fprintf(stderr, "kernel_launch: unexpected n_in %d or ws_size %zu (< %zu)\n", n_in, ws_size, (size_t)WS_END); grid_blocks = -1; return; }
        int dev = 0, cus = 0, per_cu = 0;
        hipGetDevice(&dev);
        hipDeviceGetAttribute(&cus, hipDeviceAttributeMultiprocessorCount, dev);
        if (hipFuncSetAttribute((const void*)fwd_megakernel, hipFuncAttributeMaxDynamicSharedMemorySize, LDS_BYTES) != hipSuccess) { fprintf(stderr, "kernel_launch: hipFuncSetAttribute failed\n"); grid_blocks = -1; return; }
        hipOccupancyMaxActiveBlocksPerMultiprocessor(&per_cu, (const void*)fwd_megakernel, NTHR, LDS_BYTES);
        if (per_cu < 1) { fprintf(stderr, "kernel_launch: occupancy query says %d\n", per_cu); per_cu = 1; }
        (void)hipGetLastError();
        grid_blocks = cus * per_cu;
    }
    if (grid_blocks < 0) return;
    Args a{};
    for (int i = 0; i < 18; ++i) a.in[i] = (const float*)d_in[i];
    a.out = (float*)d_out; a.ws = (unsigned char*)d_ws;
    void* kargs[] = {&a};
    hipError_t e = hipLaunchCooperativeKernel((const void*)fwd_megakernel, dim3(grid_blocks), dim3(NTHR), kargs, LDS_BYTES, stream);
    if (e != hipSuccess) fprintf(stderr, "cooperative launch failed: %s (grid %d)\n", hipGetErrorString(e), grid_blocks);
}
```

```cpp
#include <hip/hip_runtime.h>
#include <hip/hip_cooperative_groups.h>
#include <cstdio>
namespace cg = cooperative_groups;

#define LAS __attribute__((address_space(3)))
typedef unsigned short bf16_t;
typedef short bf16x8 __attribute__((ext_vector_type(8)));
typedef float f32x4 __attribute__((ext_vector_type(4)));
typedef float f32x16 __attribute__((ext_vector_type(16)));
typedef unsigned u32x4 __attribute__((ext_vector_type(4)));
typedef unsigned u32x2 __attribute__((ext_vector_type(2)));

#ifndef REP_P0
#define REP_P0 1
#endif
#ifndef REP_P1
#define REP_P1 1
#endif
#ifndef REP_P4
#define REP_P4 1
#endif
#ifndef REP_P4B
#define REP_P4B 1
#endif
#ifndef REP_P5
#define REP_P5 1
#endif
constexpr int NB = 2, SEQ = 4096, DM = 2048, MT = NB * SEQ;
constexpr int NPROJ = 14592;
constexpr int DFF = 5632, NMOD = 12288;
constexpr float ALPHA = 1.189207115002721f;
constexpr float LN_EPS = 1e-5f;
constexpr int NWAVES = 8, NTHR = 512;
constexpr int LDS_BYTES = 147456;

constexpr size_t al256(size_t x) { return (x + 255) & ~(size_t)255; }
constexpr size_t WS_PART = 1u << 20;
constexpr size_t WS_MOD  = WS_PART + al256((size_t)8 * 2 * NMOD * 4);
constexpr size_t ACT     = (size_t)MT * DM * 2;
constexpr size_t WS_WA   = WS_MOD + al256((size_t)2 * NMOD * 4);
constexpr size_t WS_WB   = WS_WA + (size_t)DM * DM * 2;
constexpr size_t WS_WO   = WS_WB + (size_t)DM * DM * 2;
constexpr size_t WS_WUP  = WS_WO + (size_t)DM * DM * 2;
constexpr size_t WS_WD   = WS_WUP + (size_t)2 * DFF * DM * 2;
constexpr size_t WS_WIN  = WS_WD + (size_t)DM * DFF * 2;
constexpr size_t WS_U    = WS_WIN + (size_t)NPROJ * DM * 2;
constexpr size_t WS_CC   = WS_U + ACT;
constexpr size_t WS_CH   = WS_CC + ACT;
constexpr size_t WS_CB   = WS_CH + ACT;
constexpr size_t WS_Q    = WS_CB + ACT;
constexpr size_t WS_GA   = WS_Q + ACT;
constexpr size_t WS_GB   = WS_GA + ACT;
constexpr size_t WS_K    = WS_GB + ACT;
constexpr size_t WS_V    = WS_K + (size_t)MT * 512 * 2;
constexpr size_t WS_VT   = WS_V + (size_t)MT * 512 * 2;
constexpr size_t WS_QI   = WS_VT + (size_t)MT * 512 * 2;
constexpr size_t WS_KW   = WS_QI + (size_t)MT * 1024 * 2;
constexpr size_t WS_KIB  = WS_KW + (size_t)MT * 256 * 2;
constexpr size_t WS_WIF  = WS_KIB + (size_t)MT * 64 * 2;
constexpr size_t WS_MASK = WS_WIF + (size_t)MT * 16 * 4;
constexpr size_t WS_END  = WS_MASK + (size_t)MT * 64 * 8;
constexpr size_t WS_SCB  = WS_WIN;
constexpr size_t WS_Z    = WS_CC;
constexpr size_t WS_HA   = WS_CC;
constexpr size_t WS_HG   = WS_CC + (size_t)MT * DFF * 2;
constexpr size_t WS_Z2   = WS_CC;
static_assert(WS_HG + (size_t)MT * DFF * 2 <= WS_K, "up-proj overlay fits in the proj region");
static_assert(WS_SCB + (size_t)MT * SEQ * 4 <= WS_CB, "score buffer fits in WIN|U|CC|CH");

__device__ __forceinline__ unsigned cvt_pk_bf16(float lo, float hi) { unsigned r; asm volatile("v_cvt_pk_bf16_f32 %0, %1, %2" : "=v"(r) : "v"(lo), "v"(hi)); return r; }
__device__ __forceinline__ float bflo(unsigned w) { return __uint_as_float(w << 16); }
__device__ __forceinline__ float bfhi(unsigned w) { return __uint_as_float(w & 0xffff0000u); }
__device__ __forceinline__ float sigmoidf_(float g) { return __builtin_amdgcn_rcpf(1.0f + __expf(-g)); }
__device__ __forceinline__ float wave_sum(float v) {
#pragma unroll
    for (int o = 1; o < 64; o <<= 1) v += __shfl_xor(v, o);
    return v;
}

namespace pg8 {
constexpr int BM = 256, BK = 64, HALF = 128, HTB = HALF * BK * 2, STAGE_BYTES = 8 * HTB, NXCD = 8, WGM = 8;
__host__ __device__ __forceinline__ int lds_byte(int r, int c) { const int st = (r >> 4) * 2 + (c >> 5), rr = r & 15, cc = c & 31, ob = rr * 64 + cc * 2; return st * 1024 + (ob ^ (((ob >> 9) & 1) << 5)); }
__host__ __device__ __forceinline__ void stage_rc(int b, int& R, int& C) { const int st = b / 1024, sb = b % 1024, swz = sb ^ (((sb >> 9) & 1) << 5); R = (st >> 1) * 16 + swz / 64; C = (st & 1) * 32 + (swz % 64) / 2; }
__host__ __device__ __forceinline__ int perm32(int rho) { const int n = rho >> 4, i = rho & 15; return 8 * (i >> 2) + 4 * n + (i & 3); }
struct Unit { int pm, pn; };
struct Gemm { const bf16_t* A; const bf16_t* Bt; int M, N, K; };
struct StaticOrder {
    int nM, nN, nwg, G, c;
    __host__ __device__ void init(int M, int N, int G_, int c_) { nM = M / BM; nN = N / BM; nwg = nM * nN; G = G_; c = c_; }
    __host__ __device__ bool next(int i, Unit& u) const {
        const long L = (long)i * G + c; if (L >= nwg) return false;
        int wgid = (int)L; { const int q = nwg / NXCD, r = nwg % NXCD, xcd = wgid % NXCD, off = wgid / NXCD; wgid = (xcd < r ? xcd * (q + 1) : r * (q + 1) + (xcd - r) * q) + off; }
        const int nig = WGM * nN, gid = wgid / nig, fm = gid * WGM, gsz = (nM - fm) < WGM ? (nM - fm) : WGM;
        u.pm = fm + ((wgid % nig) % gsz); u.pn = (wgid % nig) / gsz; return true;
    }
};
template <class Epi>
__device__ __forceinline__ void gemm_phase(LAS unsigned char* lds, const Gemm g, const StaticOrder& S, const Epi& E) {
    const int tid = threadIdx.x, wid = __builtin_amdgcn_readfirstlane(tid >> 6), lane = tid & 63, wr = wid >> 2, wc = wid & 3, fr = lane & 15, fq = lane >> 4;
    const int K = g.K, nt = K / BK;
    unsigned voffA[2], voffB[2];
#pragma unroll
    for (int i = 0; i < 2; ++i) { int R, C; stage_rc(tid * 16 + i * 8192, R, C); const int Rb = (R & ~31) + perm32(R & 31);
        voffA[i] = (unsigned)(R * K + C) * 2u; voffB[i] = (unsigned)(Rb * K + C) * 2u; }
    const size_t kstep = (size_t)(BK * 2);
    const size_t hstep = (size_t)HALF * K * 2;
    const size_t tstep = 2 * hstep;
    const unsigned ldsw = (unsigned)wid * 1024u;
    const int aoff = lds_byte(wr * 64 + fr, fq * 8), boff = lds_byte(wc * 32 + fr, fq * 8);
#define PG8_SA(b, h) (((b) * 2 + (h)) * HTB)
#define PG8_SB(b, h) ((4 + (b) * 2 + (h)) * HTB)
#define PG8_STAGE(bufoff, gbase, voff) do { _Pragma("unroll") for (int _i = 0; _i < 2; ++_i) \
        __builtin_amdgcn_global_load_lds((const unsigned*)((const char*)(gbase) + (voff)[_i]), (LAS unsigned*)(lds + (bufoff) + ldsw + _i * 8192), 16, 0, 0); } while (0)
#define PG8_LDA(dst, b, h) do { _Pragma("unroll") for (int m = 0; m < 4; ++m) _Pragma("unroll") for (int k = 0; k < 2; ++k) dst[m][k] = *(const LAS bf16x8*)(lds + PG8_SA(b, h) + aoff + m * 2048 + k * 1024); } while (0)
#define PG8_LDB(dst, b, h) do { _Pragma("unroll") for (int n = 0; n < 2; ++n) _Pragma("unroll") for (int k = 0; k < 2; ++k) dst[n][k] = *(const LAS bf16x8*)(lds + PG8_SB(b, h) + boff + n * 2048 + k * 1024); } while (0)
#define PG8_MMA(ai, bj, At, Bt) do { __builtin_amdgcn_s_setprio(1); _Pragma("unroll") for (int m = 0; m < 4; ++m) _Pragma("unroll") for (int n = 0; n < 2; ++n) _Pragma("unroll") for (int k = 0; k < 2; ++k) \
        acc[ai][bj][m][n] = __builtin_amdgcn_mfma_f32_16x16x32_bf16(Bt[n][k], At[m][k], acc[ai][bj][m][n], 0, 0, 0); __builtin_amdgcn_s_setprio(0); } while (0)
#define PG8_WAIT_V(n) asm volatile("s_waitcnt vmcnt(" #n ")" ::: "memory")
#define PG8_WAIT_L(n) asm volatile("s_waitcnt lgkmcnt(" #n ")" ::: "memory")
#define PG8_BAR __builtin_amdgcn_s_barrier()
#define PG8_SCHED __builtin_amdgcn_sched_barrier(0)
    Unit cur, nxt; int ui = 0;
    if (!S.next(0, cur)) return;
    f32x4 acc[2][2][4][2];
#pragma unroll
    for (int a = 0; a < 2; ++a)
#pragma unroll
        for (int b = 0; b < 2; ++b)
#pragma unroll
            for (int m = 0; m < 4; ++m)
#pragma unroll
                for (int n = 0; n < 2; ++n) acc[a][b][m][n] = (f32x4){0.f, 0.f, 0.f, 0.f};
    bf16x8 At[4][2], B0[2][2], B1[2][2];
    const char* cA = (const char*)g.A + (size_t)cur.pm * tstep; const char* cB = (const char*)g.Bt + (size_t)cur.pn * tstep;
    PG8_STAGE(PG8_SB(0, 0), cB, voffB); PG8_STAGE(PG8_SA(0, 0), cA, voffA); PG8_STAGE(PG8_SB(0, 1), cB + hstep, voffB); PG8_STAGE(PG8_SA(0, 1), cA + hstep, voffA);
    if (wr == 1) PG8_BAR;
    PG8_WAIT_V(4); PG8_BAR;
    PG8_STAGE(PG8_SB(1, 0), cB + kstep, voffB); PG8_STAGE(PG8_SA(1, 0), cA + kstep, voffA); PG8_STAGE(PG8_SB(1, 1), cB + hstep + kstep, voffB);
    PG8_WAIT_V(6); PG8_BAR;
    for (;;) {
        const bool has_next = S.next(ui + 1, nxt);
        const char* nA = has_next ? (const char*)g.A + (size_t)nxt.pm * tstep : cA; const char* nB = has_next ? (const char*)g.Bt + (size_t)nxt.pn * tstep : cB;
        for (int t = 0; t < nt; t += 2) {
            const bool last = (t == nt - 2);
            const char* a1 = cA + (size_t)(t + 1) * kstep;
            const char* a2 = last ? nA : cA + (size_t)(t + 2) * kstep; const char* b2 = last ? nB : cB + (size_t)(t + 2) * kstep;
            const char* a3 = a2 + kstep; const char* b3 = b2 + kstep;
            PG8_LDB(B0, 0, 0); PG8_SCHED; PG8_LDA(At, 0, 0); PG8_STAGE(PG8_SA(1, 1), a1 + hstep, voffA);
            PG8_WAIT_L(8); PG8_BAR; PG8_WAIT_L(0); PG8_MMA(0, 0, At, B0); PG8_BAR; PG8_SCHED;
            PG8_LDB(B1, 0, 1); PG8_STAGE(PG8_SB(0, 0), b2, voffB);
            PG8_BAR; PG8_WAIT_L(0); PG8_MMA(0, 1, At, B1); PG8_BAR;
            PG8_LDA(At, 0, 1); PG8_STAGE(PG8_SA(0, 0), a2, voffA);
            PG8_BAR; PG8_WAIT_L(0); PG8_MMA(1, 0, At, B0); PG8_BAR; PG8_SCHED;
            PG8_STAGE(PG8_SB(0, 1), b2 + hstep, voffB);
            PG8_WAIT_V(6); PG8_BAR; PG8_MMA(1, 1, At, B1); PG8_BAR;
            PG8_LDB(B0, 1, 0); PG8_SCHED; PG8_LDA(At, 1, 0); PG8_STAGE(PG8_SA(0, 1), a2 + hstep, voffA);
            PG8_WAIT_L(8); PG8_BAR; PG8_WAIT_L(0); PG8_MMA(0, 0, At, B0); PG8_BAR; PG8_SCHED;
            PG8_LDB(B1, 1, 1); PG8_STAGE(PG8_SB(1, 0), b3, voffB);
            PG8_BAR; PG8_WAIT_L(0); PG8_MMA(0, 1, At, B1); PG8_BAR;
            PG8_LDA(At, 1, 1); PG8_STAGE(PG8_SA(1, 0), a3, voffA);
            PG8_BAR; PG8_WAIT_L(0); PG8_MMA(1, 0, At, B0); PG8_BAR; PG8_SCHED;
            PG8_STAGE(PG8_SB(1, 1), b3 + hstep, voffB);
            PG8_WAIT_V(6); PG8_BAR; PG8_MMA(1, 1, At, B1); PG8_BAR;
        }
        E(acc, cur, wr, wc, fr, fq);
        if (!has_next) break;
#pragma unroll
        for (int a = 0; a < 2; ++a)
#pragma unroll
            for (int b = 0; b < 2; ++b)
#pragma unroll
                for (int m = 0; m < 4; ++m)
#pragma unroll
                    for (int n = 0; n < 2; ++n) acc[a][b][m][n] = (f32x4){0.f, 0.f, 0.f, 0.f};
        cur = nxt; cA = nA; cB = nB; ++ui;
    }
    PG8_WAIT_V(0);
    if (wr == 0) PG8_BAR;
    PG8_BAR;
#undef PG8_SA
#undef PG8_SB
#undef PG8_STAGE
#undef PG8_LDA
#undef PG8_LDB
#undef PG8_MMA
#undef PG8_WAIT_V
#undef PG8_WAIT_L
#undef PG8_BAR
#undef PG8_SCHED
}
}

typedef f32x4 AccT[2][2][4][2];
#define EPI_LOOP_BEGIN \
    _Pragma("unroll") for (int ai = 0; ai < 2; ++ai) _Pragma("unroll") for (int m = 0; m < 4; ++m) { \
        const int row = u.pm * 256 + ai * 128 + wr * 64 + m * 16 + fr; \
        _Pragma("unroll") for (int bj = 0; bj < 2; ++bj) { const int ct = bj * 128 + wc * 32 + 8 * fq;   \
            const f32x4 v0 = acc[ai][bj][m][0], v1 = acc[ai][bj][m][1];
#define EPI_LOOP_END } }

struct EpiProj {
    unsigned char* ws;
    __device__ __forceinline__ void operator()(const AccT& acc, const pg8::Unit& u, int wr, int wc, int fr, int fq) const {
        const int pn = u.pn; bf16_t* base; int ld, c0;
        if (pn < 8)       { base = (bf16_t*)(ws + WS_CB); ld = 2048; c0 = pn * 256; }
        else if (pn < 16) { base = (bf16_t*)(ws + WS_CC); ld = 2048; c0 = (pn - 8) * 256; }
        else if (pn < 24) { base = (bf16_t*)(ws + WS_CH); ld = 2048; c0 = (pn - 16) * 256; }
        else if (pn < 32) { base = (bf16_t*)(ws + WS_Q);  ld = 2048; c0 = (pn - 24) * 256; }
        else if (pn < 34) { base = (bf16_t*)(ws + WS_K);  ld = 512;  c0 = (pn - 32) * 256; }
        else if (pn < 36) { base = (bf16_t*)(ws + WS_V);  ld = 512;  c0 = (pn - 34) * 256; }
        else if (pn < 40) { base = (bf16_t*)(ws + WS_QI); ld = 1024; c0 = (pn - 36) * 256; }
        else if (pn < 48) { base = (bf16_t*)(ws + WS_GA); ld = 2048; c0 = (pn - 40) * 256; }
        else if (pn < 56) { base = (bf16_t*)(ws + WS_GB); ld = 2048; c0 = (pn - 48) * 256; }
        else              { base = (bf16_t*)(ws + WS_KW); ld = 256;  c0 = 0; }
        EPI_LOOP_BEGIN
            u32x4 w; w.x = cvt_pk_bf16(v0[0], v0[1]); w.y = cvt_pk_bf16(v0[2], v0[3]); w.z = cvt_pk_bf16(v1[0], v1[1]); w.w = cvt_pk_bf16(v1[2], v1[3]);
            *(u32x4*)(base + (size_t)row * ld + c0 + ct) = w;
        EPI_LOOP_END
    }
};
__device__ __forceinline__ float dpp_ror1(float x) { return __builtin_bit_cast(float, __builtin_amdgcn_update_dpp(0, __builtin_bit_cast(int, x), 0x121, 0xf, 0xf, false)); }
__device__ __forceinline__ float dpp_ror2(float x) { return __builtin_bit_cast(float, __builtin_amdgcn_update_dpp(0, __builtin_bit_cast(int, x), 0x122, 0xf, 0xf, false)); }
__device__ __forceinline__ float gelu_tanh_(float v) { const float inner = 0.7978845608028654f * (v + 0.044715f * v * v * v); return v * __builtin_amdgcn_rcpf(1.0f + __expf(-2.0f * inner)); }
struct EpiUp {
    bf16_t* HH; float* SA  ; float* SG  ; const float* cw  ;
    __device__ __forceinline__ void operator()(const AccT& acc, const pg8::Unit& u, int wr, int wc, int fr, int fq) const {
        const int c0 = u.pn * 128 + wc * 32 + 8 * fq;
        float w0[8], w1[8], w2[8];
        { const f32x4 a = *(const f32x4*)(cw + c0), b = *(const f32x4*)(cw + c0 + 4), c = *(const f32x4*)(cw + DFF + c0), d = *(const f32x4*)(cw + DFF + c0 + 4),
                      e = *(const f32x4*)(cw + 2 * DFF + c0), f = *(const f32x4*)(cw + 2 * DFF + c0 + 4);
#pragma unroll
          for (int j = 0; j < 4; ++j) { w0[j] = a[j]; w0[4 + j] = b[j]; w1[j] = c[j]; w1[4 + j] = d[j]; w2[j] = e[j]; w2[4 + j] = f[j]; } }
#pragma unroll
        for (int ai = 0; ai < 2; ++ai) {
            float pr1[8], pr2[8];
#pragma unroll
            for (int e = 0; e < 8; ++e) { pr1[e] = 0.f; pr2[e] = 0.f; }
#pragma unroll
            for (int m = 0; m < 4; ++m) {
                const int row = u.pm * 256 + ai * 128 + wr * 64 + m * 16 + fr;
                float y[8];
#pragma unroll
                for (int e = 0; e < 8; ++e) {
                    const float a = acc[ai][0][m][e >> 2][e & 3], g = acc[ai][1][m][e >> 2][e & 3];
                    const float r1 = dpp_ror1(a), r2 = dpp_ror2(a);
                    const float p1 = (fr >= 1) ? r1 : pr1[e], p2 = (fr >= 2) ? r2 : pr2[e];
                    pr1[e] = r1; pr2[e] = r2;
                    y[e] = gelu_tanh_(w0[e] * p2 + w1[e] * p1 + w2[e] * a) * g;
                }
                u32x4 w; w.x = cvt_pk_bf16(y[0], y[1]); w.y = cvt_pk_bf16(y[2], y[3]); w.z = cvt_pk_bf16(y[4], y[5]); w.w = cvt_pk_bf16(y[6], y[7]);
                *(u32x4*)(HH + (size_t)row * DFF + c0) = w;
                if (m == 0 && fr < 2) {
                    const int gi = row >> 6;
                    float* sa = SA + ((size_t)(gi * 4 + 2 + fr)) * DFF + c0; float* sg = SG + ((size_t)(gi * 2 + fr)) * DFF + c0;
                    *(f32x4*)(sa) = acc[ai][0][m][0]; *(f32x4*)(sa + 4) = acc[ai][0][m][1]; *(f32x4*)(sg) = acc[ai][1][m][0]; *(f32x4*)(sg + 4) = acc[ai][1][m][1];
                }
                if (m == 3 && fr >= 14) {
                    const int gi = (row >> 6) + 1;
                    float* sa = SA + ((size_t)(gi * 4 + (fr - 14))) * DFF + c0;
                    *(f32x4*)(sa) = acc[ai][0][m][0]; *(f32x4*)(sa + 4) = acc[ai][0][m][1];
                }
            }
        }
    }
};
struct EpiGate1 {
    const bf16_t* G; float* TMP;
    __device__ __forceinline__ void operator()(const AccT& acc, const pg8::Unit& u, int wr, int wc, int fr, int fq) const {
        EPI_LOOP_BEGIN
            const size_t off = (size_t)row * DM + u.pn * 256 + ct;
            const u32x4 g = *(const u32x4*)(G + off);
            f32x4 o0, o1;
            o0[0] = sigmoidf_(bflo(g.x)) * v0[0]; o0[1] = sigmoidf_(bfhi(g.x)) * v0[1]; o0[2] = sigmoidf_(bflo(g.y)) * v0[2]; o0[3] = sigmoidf_(bfhi(g.y)) * v0[3];
            o1[0] = sigmoidf_(bflo(g.z)) * v1[0]; o1[1] = sigmoidf_(bfhi(g.z)) * v1[1]; o1[2] = sigmoidf_(bflo(g.w)) * v1[2]; o1[3] = sigmoidf_(bfhi(g.w)) * v1[3];
            *(f32x4*)(TMP + off) = o0; *(f32x4*)(TMP + off + 4) = o1;
        EPI_LOOP_END
    }
};
struct EpiGate2 {
    const bf16_t* G; const float* TMP; bf16_t* OUT;
    __device__ __forceinline__ void operator()(const AccT& acc, const pg8::Unit& u, int wr, int wc, int fr, int fq) const {
        EPI_LOOP_BEGIN
            const size_t off = (size_t)row * DM + u.pn * 256 + ct;
            const u32x4 g = *(const u32x4*)(G + off);
            const f32x4 t0 = *(const f32x4*)(TMP + off), t1 = *(const f32x4*)(TMP + off + 4);
            f32x4 o0, o1;
            o0[0] = t0[0] + sigmoidf_(bflo(g.x)) * v0[0]; o0[1] = t0[1] + sigmoidf_(bfhi(g.x)) * v0[1]; o0[2] = t0[2] + sigmoidf_(bflo(g.y)) * v0[2]; o0[3] = t0[3] + sigmoidf_(bfhi(g.y)) * v0[3];
            o1[0] = t1[0] + sigmoidf_(bflo(g.z)) * v1[0]; o1[1] = t1[1] + sigmoidf_(bfhi(g.z)) * v1[1]; o1[2] = t1[2] + sigmoidf_(bflo(g.w)) * v1[2]; o1[3] = t1[3] + sigmoidf_(bfhi(g.w)) * v1[3];
            u32x4 w; w.x = cvt_pk_bf16(o0[0], o0[1]); w.y = cvt_pk_bf16(o0[2], o0[3]); w.z = cvt_pk_bf16(o1[0], o1[1]); w.w = cvt_pk_bf16(o1[2], o1[3]);
            *(u32x4*)(OUT + off) = w;
        EPI_LOOP_END
    }
};
struct EpiRes {
    const float* X; const float* gmod  ; float* Z;
    __device__ __forceinline__ void operator()(const AccT& acc, const pg8::Unit& u, int wr, int wc, int fr, int fq) const {
        const float* gm = gmod + (u.pm >= 16 ? NMOD : 0) + u.pn * 256;
        EPI_LOOP_BEGIN
            const size_t off = (size_t)row * DM + u.pn * 256 + ct;
            const f32x4 x0 = *(const f32x4*)(X + off), x1 = *(const f32x4*)(X + off + 4);
            const f32x4 g0 = *(const f32x4*)(gm + ct), g1 = *(const f32x4*)(gm + ct + 4);
            f32x4 o0, o1;
#pragma unroll
            for (int j = 0; j < 4; ++j) { o0[j] = ALPHA * x0[j] + (1.0f + g0[j]) * v0[j]; o1[j] = ALPHA * x1[j] + (1.0f + g1[j]) * v1[j]; }
            *(f32x4*)(Z + off) = o0; *(f32x4*)(Z + off + 4) = o1;
        EPI_LOOP_END
    }
};

template <int WIN>
__device__ __forceinline__ void transpose_item(const float* W, int K, int N, int NP, bf16_t* WT, LAS unsigned* scr, int item, int lane) {
    const int nblk = NP / 64, kb = item / nblk, nb = item % nblk, k0 = 64 * kb, n0 = 64 * nb;
    const int cl = lane & 15, kr = lane >> 4;
    const int np = n0 + 4 * cl; int sc = np; bool valid = true;
    if (WIN == 2) { const int tile = np >> 8, within = np & 255; sc = (within < 128) ? (128 * tile + within) : (DFF + 128 * tile + (within - 128)); }
    if (WIN == 1) {
        if (np < 10240) sc = np;
        else if (np < 12288) sc = 10320 + (np - 10240);
        else if (np < 14336) sc = 12368 + (np - 12288);
        else if (np < 14416) sc = 10240 + (np - 14336);
        else { valid = false; sc = 0; }
    }
    const float* src = W + (size_t)(k0 + 2 * kr) * N + sc;
    f32x4 va[8], vb[8];
#pragma unroll
    for (int i = 0; i < 8; ++i) {
        va[i] = *(const f32x4*)(src + (size_t)(8 * i) * N); vb[i] = *(const f32x4*)(src + (size_t)(8 * i + 1) * N);
        if (WIN == 1 && !valid) { va[i] = (f32x4){0.f, 0.f, 0.f, 0.f}; vb[i] = va[i]; } }
#pragma unroll
    for (int i = 0; i < 8; ++i)
#pragma unroll
        for (int j = 0; j < 4; ++j) scr[(4 * i + kr) * 65 + 4 * cl + j] = cvt_pk_bf16(va[i][j], vb[i][j]);
    asm volatile("s_waitcnt lgkmcnt(0)" ::: "memory");
    const int c = lane & 7;
#pragma unroll
    for (int j = 0; j < 8; ++j) { const int n = (lane >> 3) + 8 * j; const LAS unsigned* s = scr + (4 * c) * 65 + n;
        u32x4 o; o.x = s[0]; o.y = s[65]; o.z = s[130]; o.w = s[195];
        *(u32x4*)(WT + (size_t)(n0 + n) * K + k0 + 8 * c) = o; }
    asm volatile("s_waitcnt lgkmcnt(0)" ::: "memory");
}
__device__ __forceinline__ void transpose_rest(const float* w_a, const float* w_b, const float* w_o, const float* w_up, const float* w_down,
                                               bf16_t* WA_T, bf16_t* WB_T, bf16_t* WO_T, bf16_t* WUP_T, bf16_t* WD_T, LAS unsigned* scr, int w, int nw, int lane) {
    constexpr int I_SQ = 32 * 32, I_UP = 32 * 176, I_DN = 88 * 32;
    for (int it = w; it < 3 * I_SQ + I_UP + I_DN; it += nw) {
        int r = it;
        if (r < I_SQ) { transpose_item<0>(w_a, DM, DM, DM, WA_T, scr, r, lane); continue; } r -= I_SQ;
        if (r < I_SQ) { transpose_item<0>(w_b, DM, DM, DM, WB_T, scr, r, lane); continue; } r -= I_SQ;
        if (r < I_SQ) { transpose_item<0>(w_o, DM, DM, DM, WO_T, scr, r, lane); continue; } r -= I_SQ;
        if (r < I_UP) { transpose_item<2>(w_up, DM, 2 * DFF, 2 * DFF, WUP_T, scr, r, lane); continue; } r -= I_UP;
        transpose_item<0>(w_down, DFF, DM, DM, WD_T, scr, r, lane);
    }
}

#define XB_TMO      128
#define XB_XCNT(j)  (256  + 64 * (j))
#define XB_XSUB(j)  (1280 + 64 * (j))
#define XB_XGEN(j)  (2304 + 64 * (j))
#define XB_TOP      3328
#define XB_TOPGEN   3392
#define XCD_BAR_WORDS 3456
#define XB_SPIN_CAP (1u << 20)
__device__ __forceinline__ unsigned xb_ld(unsigned* p)              { return __hip_atomic_load(p, __ATOMIC_RELAXED, __HIP_MEMORY_SCOPE_AGENT); }
__device__ __forceinline__ unsigned xb_add(unsigned* p, unsigned v) { return __hip_atomic_fetch_add(p, v, __ATOMIC_RELAXED, __HIP_MEMORY_SCOPE_AGENT); }
__device__ __forceinline__ unsigned xb_xcc_id() { return (unsigned)__builtin_amdgcn_s_getreg((3 << 11) | 20) & 0xFu; }
#define XB_SPIN(cond, bar) do { unsigned _sp = 0; while (cond) { __builtin_amdgcn_s_sleep(1); \
    if ((++_sp & 255u) == 0u) { if (xb_ld(&(bar)[XB_TMO])) break; if (_sp > XB_SPIN_CAP) { atomicAdd(&(bar)[XB_TMO], 1u); break; } } } } while (0)
struct XcdBarrier { unsigned* bar; unsigned x; volatile LAS unsigned* st; };
__device__ __forceinline__ XcdBarrier xcd_barrier_post(unsigned* bar, volatile LAS unsigned* st) {
    XcdBarrier b; b.bar = bar; b.x = xb_xcc_id(); b.st = st;
    if (threadIdx.x == 0) (void)xb_add(&bar[XB_XCNT(b.x)], 1u);
    return b;
}
__device__ __forceinline__ void xcd_barrier_complete(unsigned* bar, unsigned x, unsigned& nloc, unsigned& nx) {
    const unsigned G = gridDim.x * gridDim.y * gridDim.z;
    unsigned sum, cnt, mine, sp = 0u;
    for (;;) {
        sum = 0u; cnt = 0u; mine = 0u;
#pragma unroll
        for (unsigned j = 0; j < 16; ++j) { const unsigned c = xb_ld(&bar[XB_XCNT(j)]); sum += c; cnt += (c > 0u) ? 1u : 0u; mine = (j == x) ? c : mine; }
        if (sum == G) break;
        __builtin_amdgcn_s_sleep(1);
        if ((++sp & 255u) == 0u) { if (xb_ld(&bar[XB_TMO])) break; if (sp > XB_SPIN_CAP) { atomicAdd(&bar[XB_TMO], 1u); break; } }
    }
    nloc = mine > 0u ? mine : 1u; nx = cnt > 0u ? cnt : 1u;
}
__device__ __forceinline__ void xcd_barrier(const XcdBarrier& b) {
    asm volatile("s_waitcnt vmcnt(0)" ::: "memory");
    __syncthreads();
    if (threadIdx.x == 0) {
        unsigned* bar = b.bar;
        __builtin_amdgcn_s_waitcnt(0);
        unsigned nloc = b.st[0], nx = b.st[1];
        if (nloc == 0u) { xcd_barrier_complete(bar, b.x, nloc, nx); b.st[0] = nloc; b.st[1] = nx; }
        const unsigned old = xb_add(&bar[XB_XSUB(b.x)], 1u);
        const unsigned gen = old / nloc;
        if (old + 1u == (gen + 1u) * nloc) {
            __builtin_amdgcn_fence(__ATOMIC_RELEASE, "agent");
            asm volatile("s_waitcnt vmcnt(0)" ::: "memory");
            const unsigned og = xb_add(&bar[XB_TOP], 1u);
            const unsigned tg = og / nx;
            if (og + 1u == (tg + 1u) * nx) xb_add(&bar[XB_TOPGEN], 1u);
            else XB_SPIN(xb_ld(&bar[XB_TOPGEN]) == tg, bar);
            __builtin_amdgcn_fence(__ATOMIC_ACQUIRE, "agent");
            xb_add(&bar[XB_XGEN(b.x)], 1u);
            asm volatile("s_waitcnt vmcnt(0)" ::: "memory");
        } else {
            XB_SPIN(xb_ld(&bar[XB_XGEN(b.x)]) == gen, bar);
            __builtin_amdgcn_fence(__ATOMIC_ACQUIRE, "agent");
            asm volatile("s_waitcnt vmcnt(0)" ::: "memory");
        }
    }
    __syncthreads();
}

struct Args { const float* in[18]; float* out; unsigned char* ws; };

__global__ void __launch_bounds__(NTHR, 2) fwd_megakernel(Args args) {
    extern __shared__ __attribute__((aligned(16))) unsigned char lds_raw[];
    LAS unsigned char* lds = (LAS unsigned char*)lds_raw;
    cg::grid_group grid = cg::this_grid();
    const int tid = threadIdx.x, lane = tid & 63, wave = __builtin_amdgcn_readfirstlane(tid >> 6);
    const int G = gridDim.x, bx = blockIdx.x;
    const int vcu = (G % 8 == 0) ? (bx % 8) * (G / 8) + bx / 8 : bx;
    const int gw = vcu * NWAVES + wave, NGW = G * NWAVES;
    const int gtid = vcu * NTHR + tid, NGT = G * NTHR;

    const float* x = args.in[0]; const float* cvec = args.in[1]; const float* w_cond = args.in[2]; const float* b_cond = args.in[3];
    const float* w_in = args.in[4]; const float* conv_a = args.in[5]; const float* kn_g = args.in[6]; const float* kn_b = args.in[7];
    const float* w_a = args.in[8]; const float* w_b = args.in[9]; const float* w_o = args.in[10]; const float* ln1_g = args.in[11]; const float* ln1_b = args.in[12];
    const float* w_up = args.in[13]; const float* conv_f = args.in[14]; const float* w_down = args.in[15]; const float* ln2_g = args.in[16]; const float* ln2_b = args.in[17];
    float* out = args.out; unsigned char* ws = args.ws;
    float* PART = (float*)(ws + WS_PART); float* MOD = (float*)(ws + WS_MOD);
    bf16_t* WIN_T = (bf16_t*)(ws + WS_WIN); bf16_t* WA_T = (bf16_t*)(ws + WS_WA); bf16_t* WB_T = (bf16_t*)(ws + WS_WB); bf16_t* WO_T = (bf16_t*)(ws + WS_WO);
    bf16_t* WUP_T = (bf16_t*)(ws + WS_WUP); bf16_t* WD_T = (bf16_t*)(ws + WS_WD);
    bf16_t* U = (bf16_t*)(ws + WS_U);
    bf16_t* CB = (bf16_t*)(ws + WS_CB); bf16_t* CC = (bf16_t*)(ws + WS_CC); bf16_t* CH = (bf16_t*)(ws + WS_CH); bf16_t* Q = (bf16_t*)(ws + WS_Q);
    bf16_t* GA = (bf16_t*)(ws + WS_GA); bf16_t* GB = (bf16_t*)(ws + WS_GB); bf16_t* KB = (bf16_t*)(ws + WS_K); bf16_t* VB = (bf16_t*)(ws + WS_V);
    bf16_t* VT = (bf16_t*)(ws + WS_VT); bf16_t* QI = (bf16_t*)(ws + WS_QI); bf16_t* KW = (bf16_t*)(ws + WS_KW); bf16_t* KIB = (bf16_t*)(ws + WS_KIB);
    float* WIF = (float*)(ws + WS_WIF); unsigned long long* MASK = (unsigned long long*)(ws + WS_MASK); unsigned* SCB = (unsigned*)(ws + WS_SCB);
    float* Z = (float*)(ws + WS_Z); float* Z2 = (float*)(ws + WS_Z2); bf16_t* HG = (bf16_t*)(ws + WS_HG); float* SA = (float*)(ws + WS_HA); float* SG = (float*)(ws + WS_HA + (size_t)129 * 4 * DFF * 4);
    float* X1 = out; float* TMP = out;
    unsigned* BARW = (unsigned*)ws;
    volatile LAS unsigned* bst = (volatile LAS unsigned*)(lds + 131072);
    if (tid < 2) bst[tid] = 0u;
    if (bx == 0) for (int i = tid; i < XCD_BAR_WORDS; i += NTHR) __hip_atomic_store(BARW + i, 0u, __ATOMIC_RELAXED, __HIP_MEMORY_SCOPE_AGENT);

    for (int rep_ = 0; rep_ < REP_P0; ++rep_) {
    {
        LAS float* cact = (LAS float*)lds;
        for (int i = tid; i < 2 * DM; i += NTHR) { const float c = cvec[i]; cact[i] = c / (1.0f + __expf(-c)); }
        __syncthreads();
        for (int item = gw; item < 8 * 192; item += NGW) {
            const int kc = item / 192, cb = item % 192, col = cb * 64 + (lane & 15) * 4, kq = lane >> 4;
            f32x4 a0 = {0.f, 0.f, 0.f, 0.f}, a1 = {0.f, 0.f, 0.f, 0.f};
            const float* wp = w_cond + (size_t)(kc * 256 + kq) * NMOD + col;
#pragma unroll 8
            for (int i = 0; i < 64; ++i) { const f32x4 w = *(const f32x4*)(wp + (size_t)(4 * i) * NMOD); const int k = kc * 256 + kq + 4 * i;
                const float s0 = cact[k], s1 = cact[DM + k]; a0 += s0 * w; a1 += s1 * w; }
#pragma unroll
            for (int j = 0; j < 4; ++j) { a0[j] += __shfl_xor(a0[j], 16); a0[j] += __shfl_xor(a0[j], 32); a1[j] += __shfl_xor(a1[j], 16); a1[j] += __shfl_xor(a1[j], 32); }
            if (lane < 16) { *(f32x4*)(PART + (size_t)(kc * 2 + 0) * NMOD + col) = a0; *(f32x4*)(PART + (size_t)(kc * 2 + 1) * NMOD + col) = a1; }
        }
        LAS unsigned* scr = (LAS unsigned*)(lds + 16384 + wave * 8448);
        for (int it = gw; it < 32 * (NPROJ / 64); it += NGW) transpose_item<1>(w_in, DM, 14416, NPROJ, WIN_T, scr, it, lane);
    }
    __syncthreads();
    }
    grid.sync();
    const XcdBarrier xbar = xcd_barrier_post(BARW, bst);

    for (int rep_ = 0; rep_ < REP_P1; ++rep_) {
    {
        for (int idx = gtid; idx < 2 * NMOD; idx += NGT) { const int b = idx / NMOD, e = idx % NMOD; float s = b_cond[e];
#pragma unroll
            for (int kc = 0; kc < 8; ++kc) s += PART[(size_t)(kc * 2 + b) * NMOD + e];
            MOD[idx] = s; }
        for (int rb = vcu; rb < MT / 32; rb += G) {
            const int b = rb >> 7, col = (tid & 255) * 8, r0 = rb * 32 + (tid >> 8) * 16;
            f32x4 sh0 = *(const f32x4*)(b_cond + col), sh1 = *(const f32x4*)(b_cond + col + 4), sc0 = *(const f32x4*)(b_cond + DM + col), sc1 = *(const f32x4*)(b_cond + DM + col + 4);
#pragma unroll
            for (int kc = 0; kc < 8; ++kc) { const float* p = PART + (size_t)(kc * 2 + b) * NMOD + col;
                sh0 += *(const f32x4*)(p); sh1 += *(const f32x4*)(p + 4); sc0 += *(const f32x4*)(p + DM); sc1 += *(const f32x4*)(p + DM + 4); }
#pragma unroll 4
            for (int r = 0; r < 16; ++r) { const size_t off = (size_t)(r0 + r) * DM + col;
                const f32x4 x0 = *(const f32x4*)(x + off), x1 = *(const f32x4*)(x + off + 4);
                f32x4 u0, u1;
#pragma unroll
                for (int j = 0; j < 4; ++j) { u0[j] = x0[j] * (1.0f + sc0[j]) + sh0[j]; u1[j] = x1[j] * (1.0f + sc1[j]) + sh1[j]; }
                u32x4 w; w.x = cvt_pk_bf16(u0[0], u0[1]); w.y = cvt_pk_bf16(u0[2], u0[3]); w.z = cvt_pk_bf16(u1[0], u1[1]); w.w = cvt_pk_bf16(u1[2], u1[3]);
                *(u32x4*)(U + off) = w; }
        }
    }
    xcd_barrier(xbar);
    }

    {
        pg8::Gemm g{U, WIN_T, MT, NPROJ, DM}; pg8::StaticOrder S; S.init(MT, NPROJ, G, bx);
        { pg8::Unit tu; const int nfull = (MT / 256) * (NPROJ / 256) - 7 * G;
          if (nfull > 0 && nfull < G && !S.next(7, tu)) { LAS unsigned* scr = (LAS unsigned*)(lds + wave * 8448);
              transpose_rest(w_a, w_b, w_o, w_up, w_down, WA_T, WB_T, WO_T, WUP_T, WD_T, scr, (bx - nfull) * NWAVES + wave, (G - nfull) * NWAVES, lane); }
          else if (!(nfull > 0 && nfull < G)) { LAS unsigned* scr = (LAS unsigned*)(lds + wave * 8448);
              transpose_rest(w_a, w_b, w_o, w_up, w_down, WA_T, WB_T, WO_T, WUP_T, WD_T, scr, gw, NGW, lane); } }
        __syncthreads();
        EpiProj E{ws};
        pg8::gemm_phase<EpiProj>(lds, g, S, E);
    }
    xcd_barrier(xbar);

    {
        for (int un = gtid; un < (MT / 16) * 256; un += NGT) {
            const int cg8 = un & 255, rb = un >> 8, col = cg8 * 8, m0 = rb * 16, t0 = m0 & (SEQ - 1);
            float w0[8], w1[8], w2[8], p1[8], p2[8];
#pragma unroll
            for (int j = 0; j < 8; ++j) { w0[j] = conv_a[col + j]; w1[j] = conv_a[DM + col + j]; w2[j] = conv_a[2 * DM + col + j]; p1[j] = 0.f; p2[j] = 0.f; }
            if (t0 != 0) {
                const u32x4 c2 = *(const u32x4*)(CC + (size_t)(m0 - 2) * DM + col), h2 = *(const u32x4*)(CH + (size_t)(m0 - 2) * DM + col);
                const u32x4 c1 = *(const u32x4*)(CC + (size_t)(m0 - 1) * DM + col), h1 = *(const u32x4*)(CH + (size_t)(m0 - 1) * DM + col);
#pragma unroll
                for (int j = 0; j < 4; ++j) { p2[2 * j] = bflo(c2[j]) * bflo(h2[j]); p2[2 * j + 1] = bfhi(c2[j]) * bfhi(h2[j]); p1[2 * j] = bflo(c1[j]) * bflo(h1[j]); p1[2 * j + 1] = bfhi(c1[j]) * bfhi(h1[j]); }
            }
#pragma unroll 4
            for (int r = 0; r < 16; ++r) { const size_t off = (size_t)(m0 + r) * DM + col;
                const u32x4 cc = *(const u32x4*)(CC + off), ch = *(const u32x4*)(CH + off), cb = *(const u32x4*)(CB + off);
                float p0[8], y[8];
#pragma unroll
                for (int j = 0; j < 4; ++j) { p0[2 * j] = bflo(cc[j]) * bflo(ch[j]); p0[2 * j + 1] = bfhi(cc[j]) * bfhi(ch[j]); }
#pragma unroll
                for (int j = 0; j < 8; ++j) { const float cv = w0[j] * p2[j] + w1[j] * p1[j] + w2[j] * p0[j]; const float cbv = (j & 1) ? bfhi(cb[j >> 1]) : bflo(cb[j >> 1]); y[j] = cbv * cv; p2[j] = p1[j]; p1[j] = p0[j]; }
                u32x4 w; w.x = cvt_pk_bf16(y[0], y[1]); w.y = cvt_pk_bf16(y[2], y[3]); w.z = cvt_pk_bf16(y[4], y[5]); w.w = cvt_pk_bf16(y[6], y[7]);
                *(u32x4*)(CB + off) = w; }
        }
        for (int un = vcu; un < NB * 4 * 64; un += G) {
            const int sb = un & 63, n = (un >> 6) & 3, b = un >> 8;
            LAS unsigned short* tl = (LAS unsigned short*)lds;
            __syncthreads();
#pragma unroll
            for (int j = 0; j < 2; ++j) { const int q = tid + 512 * j, row = q >> 4, ch = q & 15;
                const u32x4 v = *(const u32x4*)(VB + (size_t)(b * SEQ + sb * 64 + row) * 512 + n * 128 + ch * 8);
                LAS unsigned* d = (LAS unsigned*)(tl + row * 130 + ch * 8); d[0] = v.x; d[1] = v.y; d[2] = v.z; d[3] = v.w; }
            __syncthreads();
#pragma unroll
            for (int j = 0; j < 2; ++j) { const int q = tid + 512 * j, s8 = q & 7, d = q >> 3;
                unsigned e[8];
#pragma unroll
                for (int k = 0; k < 8; ++k) e[k] = tl[(s8 * 8 + k) * 130 + d];
                u32x4 w; w.x = e[0] | (e[1] << 16); w.y = e[2] | (e[3] << 16); w.z = e[4] | (e[5] << 16); w.w = e[6] | (e[7] << 16);
                *(u32x4*)(VT + ((size_t)((b * 4 + n) * 128 + d)) * SEQ + sb * 64 + s8 * 8) = w; }
        }
        __syncthreads();
        for (int m = gtid; m < MT; m += NGT) {
            float v[64]; float s = 0.f;
#pragma unroll
            for (int j = 0; j < 8; ++j) { const u32x4 w = *(const u32x4*)(KW + (size_t)m * 256 + j * 8);
#pragma unroll
                for (int k = 0; k < 4; ++k) { v[j * 8 + 2 * k] = bflo(w[k]); v[j * 8 + 2 * k + 1] = bfhi(w[k]); } }
#pragma unroll
            for (int j = 0; j < 64; ++j) s += v[j];
            const float mu = s * (1.0f / 64.0f); float s2 = 0.f;
#pragma unroll
            for (int j = 0; j < 64; ++j) { v[j] -= mu; s2 += v[j] * v[j]; }
            const float rstd = rsqrtf(s2 * (1.0f / 64.0f) + LN_EPS);
#pragma unroll
            for (int j = 0; j < 8; ++j) { u32x4 w;
#pragma unroll
                for (int k = 0; k < 4; ++k) { const int e = j * 8 + 2 * k; w[k] = cvt_pk_bf16(v[e] * rstd * kn_g[e] + kn_b[e], v[e + 1] * rstd * kn_g[e + 1] + kn_b[e + 1]); }
                *(u32x4*)(KIB + (size_t)m * 64 + j * 8) = w; }
#pragma unroll
            for (int j = 0; j < 2; ++j) { const u32x4 w = *(const u32x4*)(KW + (size_t)m * 256 + 64 + j * 8);
                f32x4 a, b2; a[0] = bflo(w.x); a[1] = bfhi(w.x); a[2] = bflo(w.y); a[3] = bfhi(w.y); b2[0] = bflo(w.z); b2[1] = bfhi(w.z); b2[2] = bflo(w.w); b2[3] = bfhi(w.w);
                *(f32x4*)(WIF + (size_t)m * 16 + j * 8) = a; *(f32x4*)(WIF + (size_t)m * 16 + j * 8 + 4) = b2; }
        }
    }
    xcd_barrier(xbar);

    for (int rep_ = 0; rep_ < REP_P4; ++rep_) {
    for (int it0 = vcu; it0 < 256; it0 += G) {
        const int cc0 = it0 & 31, q16 = (it0 >> 5) & 3, b = it0 >> 7;
        for (int half = 0; half < 2; ++half) {
            const int c = half ? 63 - cc0 : cc0, nblk = c + 1, ntile = (nblk + 3) >> 2;
            const int m0 = b * SEQ + 64 * c + q16 * 16 + wave * 2;
            const int kk = lane & 15, quad = lane >> 4;
            bf16x8 a0[2], a1[2]; f32x4 w4[2];
#pragma unroll
            for (int qq = 0; qq < 2; ++qq) { const bf16_t* qp = QI + (size_t)(m0 + qq) * 1024 + kk * 64 + quad * 8;
                a0[qq] = *(const bf16x8*)(qp); a1[qq] = *(const bf16x8*)(qp + 32); w4[qq] = *(const f32x4*)(WIF + (size_t)(m0 + qq) * 16 + quad * 4); }
            const bf16_t* ksrc = KIB + (size_t)(b * SEQ) * 64 + (size_t)tid * 8;
            int kdst[4];
#pragma unroll
            for (int j = 0; j < 4; ++j) { const int q = tid + 512 * j, key = q >> 3, ch = q & 7; kdst[j] = key * 128 + ((ch ^ (key & 7)) << 4); }
            const int rd0 = kk * 128 + (((quad) ^ (kk & 7)) << 4), rd1 = kk * 128 + (((quad + 4) ^ (kk & 7)) << 4);
            u32x4 pf[4];
#pragma unroll
            for (int j = 0; j < 4; ++j) pf[j] = *(const u32x4*)(ksrc + (size_t)j * 4096);
#pragma unroll
            for (int j = 0; j < 4; ++j) *(LAS u32x4*)(lds + kdst[j]) = pf[j];
            if (ntile > 1) {
#pragma unroll
                for (int j = 0; j < 4; ++j) pf[j] = *(const u32x4*)(ksrc + (size_t)16384 + (size_t)j * 4096);
#pragma unroll
                for (int j = 0; j < 4; ++j) *(LAS u32x4*)(lds + 32768 + kdst[j]) = pf[j];
            }
            __syncthreads();
            unsigned* so0 = SCB + (size_t)m0 * SEQ + lane; unsigned* so1 = so0 + SEQ;
            for (int tile = 0; tile < ntile; ++tile) {
                const int buf = (tile % 3) * 32768;
                if (tile + 2 < ntile) {
#pragma unroll
                    for (int j = 0; j < 4; ++j) pf[j] = *(const u32x4*)(ksrc + (size_t)(tile + 2) * 16384 + (size_t)j * 4096); }
#pragma unroll
                for (int ii = 0; ii < 4; ++ii) {
                    const int i = 4 * tile + ii;
                    {
                        bf16x8 k0[4], k1[4];
#pragma unroll
                        for (int g = 0; g < 4; ++g) { const LAS unsigned char* kp = lds + buf + (64 * ii + 16 * g) * 128; k0[g] = *(const LAS bf16x8*)(kp + rd0); k1[g] = *(const LAS bf16x8*)(kp + rd1); }
#pragma unroll
                        for (int qq = 0; qq < 2; ++qq) {
                            f32x4 acc[4];
#pragma unroll
                            for (int g = 0; g < 4; ++g) { acc[g] = (f32x4){0.f, 0.f, 0.f, 0.f}; acc[g] = __builtin_amdgcn_mfma_f32_16x16x32_bf16(a0[qq], k0[g], acc[g], 0, 0, 0); }
#pragma unroll
                            for (int g = 0; g < 4; ++g) acc[g] = __builtin_amdgcn_mfma_f32_16x16x32_bf16(a1[qq], k1[g], acc[g], 0, 0, 0);
                            float v[4];
#pragma unroll
                            for (int g = 0; g < 4; ++g)
                                v[g] = w4[qq][0] * __builtin_amdgcn_fmed3f(acc[g][0], 0.f, INFINITY) + w4[qq][1] * __builtin_amdgcn_fmed3f(acc[g][1], 0.f, INFINITY)
                                     + w4[qq][2] * __builtin_amdgcn_fmed3f(acc[g][2], 0.f, INFINITY) + w4[qq][3] * __builtin_amdgcn_fmed3f(acc[g][3], 0.f, INFINITY);
                            const auto sA = __builtin_amdgcn_permlane16_swap(__float_as_uint(v[0]), __float_as_uint(v[1]), false, false);
                            const auto sB = __builtin_amdgcn_permlane16_swap(__float_as_uint(v[2]), __float_as_uint(v[3]), false, false);
                            const float t0 = __uint_as_float(sA[0]) + __uint_as_float(sA[1]), t1 = __uint_as_float(sB[0]) + __uint_as_float(sB[1]);
                            const auto sC = __builtin_amdgcn_permlane32_swap(__float_as_uint(t0), __float_as_uint(t1), false, false);
                            const float fin = __uint_as_float(sC[0]) + __uint_as_float(sC[1]);
                            const unsigned ub = __float_as_uint(fin);
                            const unsigned key = (ub & 0x80000000u) ? ~ub : (ub | 0x80000000u);
                            (qq ? so1 : so0)[64 * i] = key;
                        }
                    }
                }
                if (tile + 2 < ntile) { const int wb = ((tile + 2) % 3) * 32768;
#pragma unroll
                    for (int j = 0; j < 4; ++j) *(LAS u32x4*)(lds + wb + kdst[j]) = pf[j]; }
                __syncthreads();
            }
        }
    }
    xcd_barrier(xbar);
    }
    for (int rep_ = 0; rep_ < REP_P4B; ++rep_) {
    for (int wq = gw; wq < 2048; wq += NGW) {
        const int c0 = wq >> 5, jt = wq & 31;
        for (int r = 0; r < 4; ++r) {
            const int b = r & 1, hh = r >> 1, tok = jt + 32 * hh, c = hh ? 63 - c0 : c0;
            const int m = b * SEQ + 64 * c + tok, nblk = c + 1;
            unsigned long long myword = 0ull;
            if (nblk <= 4) {
                if (lane < nblk) myword = ~0ull;
            } else {
                unsigned sc[64];
                const unsigned* sp = SCB + (size_t)m * SEQ + lane;
#pragma unroll
                for (int g8 = 0; g8 < 8; ++g8) {
                    if (g8 * 8 < nblk) {
#pragma unroll
                        for (int e = 0; e < 8; ++e) { const int i = g8 * 8 + e; sc[i] = (i < nblk) ? sp[64 * i] : 0u; }
                    } else {
#pragma unroll
                        for (int e = 0; e < 8; ++e) sc[g8 * 8 + e] = 0u;
                    }
                }
                unsigned T = 0u; bool exact = false;
                for (int bit = 31; bit >= 0; --bit) {
                    const unsigned cand = T | (1u << bit);
                    int cnt = 0;
#pragma unroll
                    for (int g8 = 0; g8 < 8; ++g8) {
                        if (g8 * 8 < nblk) {
                            unsigned long long mk[8];
                            asm("v_cmp_le_u32_e64 %0, %8, %9\n\tv_cmp_le_u32_e64 %1, %8, %10\n\tv_cmp_le_u32_e64 %2, %8, %11\n\tv_cmp_le_u32_e64 %3, %8, %12\n\t"
                                "v_cmp_le_u32_e64 %4, %8, %13\n\tv_cmp_le_u32_e64 %5, %8, %14\n\tv_cmp_le_u32_e64 %6, %8, %15\n\tv_cmp_le_u32_e64 %7, %8, %16"
                                : "=&s"(mk[0]), "=&s"(mk[1]), "=&s"(mk[2]), "=&s"(mk[3]), "=&s"(mk[4]), "=&s"(mk[5]), "=&s"(mk[6]), "=&s"(mk[7])
                                : "v"(cand), "v"(sc[g8 * 8 + 0]), "v"(sc[g8 * 8 + 1]), "v"(sc[g8 * 8 + 2]), "v"(sc[g8 * 8 + 3]), "v"(sc[g8 * 8 + 4]), "v"(sc[g8 * 8 + 5]), "v"(sc[g8 * 8 + 6]), "v"(sc[g8 * 8 + 7]));
#pragma unroll
                            for (int e = 0; e < 8; ++e) cnt += __builtin_popcountll(mk[e]);
                        }
                    }
                    if (cnt >= 256) { T = cand; if (cnt == 256) { exact = true; break; } }
                }
                if (exact) {
#pragma unroll
                    for (int i = 0; i < 64; ++i) { const unsigned long long word = __ballot(sc[i] >= T); if (lane == i) myword = word; }
                } else {
                    int cgt = 0;
#pragma unroll
                    for (int i = 0; i < 64; ++i) cgt += __popcll(__ballot(sc[i] > T));
                    int need = 256 - cgt;
#pragma unroll
                    for (int i = 0; i < 64; ++i) {
                        const unsigned long long gt = __ballot(sc[i] > T), eq = __ballot(sc[i] == T);
                        unsigned long long sel = 0ull;
                        if (eq != 0ull && need > 0) {
                            const int ne = __popcll(eq);
                            if (ne <= need) { sel = eq; need -= ne; }
                            else { unsigned long long tmp = eq; for (int k = 0; k < need; ++k) { const unsigned long long low = tmp & (0ull - tmp); sel |= low; tmp ^= low; } need = 0; }
                        }
                        const unsigned long long word = gt | sel;
                        if (lane == i) myword = word;
                    }
                }
            }
            MASK[(size_t)m * 64 + lane] = myword;
        }
    }
    xcd_barrier(xbar);
    }

    for (int rep_ = 0; rep_ < REP_P5; ++rep_) {
    for (int it0 = vcu; it0 < 256; it0 += G) {
        const int cc0 = it0 & 31, n = (it0 >> 5) & 3, b = it0 >> 7;
        for (int half = 0; half < 2; ++half) {
            const int c = half ? 63 - cc0 : cc0, nblk = c + 1;
            const int h = lane >> 5, r = lane & 31;
            const int hq = 4 * n + (wave >> 1), th = wave & 1;
            const int mq = b * SEQ + 64 * c + 32 * th + r;
            bf16x8 qf[8];
            { const bf16_t* qp = Q + (size_t)mq * DM + hq * 128 + 8 * h;
#pragma unroll
              for (int ks = 0; ks < 8; ++ks) qf[ks] = *(const bf16x8*)(qp + ks * 16); }
            f32x16 o[4];
#pragma unroll
            for (int dt = 0; dt < 4; ++dt)
#pragma unroll
                for (int i = 0; i < 16; ++i) o[dt][i] = 0.f;
            float mrun = -INFINITY, lrun = 0.f;
            const int kq0 = tid, kq1 = tid + 512;
            const bf16_t* ksrc0 = KB + (size_t)(b * SEQ + (kq0 >> 4)) * 512 + n * 128 + (kq0 & 15) * 8;
            const bf16_t* ksrc1 = KB + (size_t)(b * SEQ + (kq1 >> 4)) * 512 + n * 128 + (kq1 & 15) * 8;
            const int kd0 = (kq0 >> 4) * 272 + (kq0 & 15) * 16, kd1 = (kq1 >> 4) * 272 + (kq1 & 15) * 16;
            const bf16_t* vsrc0 = VT + ((size_t)((b * 4 + n) * 128 + (kq0 >> 3))) * SEQ + (kq0 & 7) * 8;
            const bf16_t* vsrc1 = VT + ((size_t)((b * 4 + n) * 128 + (kq1 >> 3))) * SEQ + (kq1 & 7) * 8;
            const int vd0 = 17408 + (kq0 >> 3) * 136 + (kq0 & 7) * 16, vd1 = 17408 + (kq1 >> 3) * 136 + (kq1 & 7) * 16;
            u32x4 pk0, pk1, pv0, pv1;
            pk0 = *(const u32x4*)(ksrc0); pk1 = *(const u32x4*)(ksrc1); pv0 = *(const u32x4*)(vsrc0); pv1 = *(const u32x4*)(vsrc1);
            {
                *(LAS u32x4*)(lds + kd0) = pk0; *(LAS u32x4*)(lds + kd1) = pk1;
                *(LAS u32x2*)(lds + vd0) = (u32x2){pv0.x, pv0.y}; *(LAS u32x2*)(lds + vd0 + 8) = (u32x2){pv0.z, pv0.w};
                *(LAS u32x2*)(lds + vd1) = (u32x2){pv1.x, pv1.y}; *(LAS u32x2*)(lds + vd1 + 8) = (u32x2){pv1.z, pv1.w};
            }
            __syncthreads();
            const unsigned long long* mrow = MASK + (size_t)mq * 64;
            unsigned long long mwn = mrow[0];
            for (int kt = 0; kt < nblk; ++kt) {
                const int buf = (kt & 1) * 34816;
                const bool more = (kt + 1 < nblk);
                if (more) { const size_t ko = (size_t)(kt + 1) * 64 * 512, vo = (size_t)(kt + 1) * 64;
                    pk0 = *(const u32x4*)(ksrc0 + ko); pk1 = *(const u32x4*)(ksrc1 + ko); pv0 = *(const u32x4*)(vsrc0 + vo); pv1 = *(const u32x4*)(vsrc1 + vo); }
                const unsigned long long mw = mwn;
                if (more) mwn = mrow[kt + 1];
                f32x16 st[2];
#pragma unroll
                for (int sub = 0; sub < 2; ++sub) {
#pragma unroll
                    for (int i = 0; i < 16; ++i) st[sub][i] = 0.f;
                    const LAS unsigned char* kb = lds + buf + (32 * sub + r) * 272 + h * 16;
#pragma unroll
                    for (int k4 = 0; k4 < 2; ++k4) {
                        bf16x8 kf[4];
#pragma unroll
                        for (int ks = 0; ks < 4; ++ks) kf[ks] = *(const LAS bf16x8*)(kb + (4 * k4 + ks) * 32);
#pragma unroll
                        for (int ks = 0; ks < 4; ++ks) st[sub] = __builtin_amdgcn_mfma_f32_32x32x16_bf16(kf[ks], qf[4 * k4 + ks], st[sub], 0, 0, 0);
                        __builtin_amdgcn_sched_group_barrier(0x100, 4, 0); __builtin_amdgcn_sched_group_barrier(0x008, 4, 0);
                    }
                }
                constexpr float CSC = 0.08838834764831845f * 1.4426950408889634f;
                float mx = -INFINITY;
#pragma unroll
                for (int sub = 0; sub < 2; ++sub) { const unsigned w = (unsigned)(sub ? (mw >> 32) : (mw & 0xffffffffull)) >> (4 * h);
#pragma unroll
                    for (int i = 0; i < 16; ++i) { const int pos = (i & 3) + 8 * (i >> 2);
                        const float sv = ((w >> pos) & 1u) ? st[sub][i] * CSC : -INFINITY; st[sub][i] = sv; mx = fmaxf(mx, sv); } }
                { const auto sw = __builtin_amdgcn_permlane32_swap(__float_as_uint(mx), __float_as_uint(mx), false, false); mx = fmaxf(__uint_as_float(sw[0]), __uint_as_float(sw[1])); }
                const float mnew = fmaxf(mrun, mx), msafe = (mnew == -INFINITY) ? 0.f : mnew;
                const bool grow = __any(mnew > mrun);
                const float alpha = __builtin_amdgcn_exp2f(mrun - msafe);
                float ls = 0.f;
#pragma unroll
                for (int sub = 0; sub < 2; ++sub)
#pragma unroll
                    for (int i = 0; i < 16; ++i) { const float p = __builtin_amdgcn_exp2f(st[sub][i] - msafe); st[sub][i] = p; ls += p; }
                lrun = lrun * alpha + ls; mrun = mnew;
                if (grow) {
#pragma unroll
                    for (int dt = 0; dt < 4; ++dt)
#pragma unroll
                        for (int i = 0; i < 16; ++i) o[dt][i] *= alpha;
                }
#pragma unroll
                for (int sub = 0; sub < 2; ++sub)
#pragma unroll
                    for (int s = 0; s < 2; ++s) {
                        u32x4 pw; pw.x = cvt_pk_bf16(st[sub][8 * s + 0], st[sub][8 * s + 1]); pw.y = cvt_pk_bf16(st[sub][8 * s + 2], st[sub][8 * s + 3]);
                        pw.z = cvt_pk_bf16(st[sub][8 * s + 4], st[sub][8 * s + 5]); pw.w = cvt_pk_bf16(st[sub][8 * s + 6], st[sub][8 * s + 7]);
                        const bf16x8 pf = __builtin_bit_cast(bf16x8, pw);
                        u32x4 vw[4];
#pragma unroll
                        for (int dt = 0; dt < 4; ++dt) {
                            const LAS unsigned char* vp = lds + buf + 17408 + (32 * dt + r) * 136 + (32 * sub + 16 * s + 4 * h) * 2;
                            const u32x2 lo = *(const LAS u32x2*)(vp), hi = *(const LAS u32x2*)(vp + 16);
                            vw[dt] = (u32x4){lo.x, lo.y, hi.x, hi.y};
                        }
#pragma unroll
                        for (int dt = 0; dt < 4; ++dt) o[dt] = __builtin_amdgcn_mfma_f32_32x32x16_bf16(__builtin_bit_cast(bf16x8, vw[dt]), pf, o[dt], 0, 0, 0);
                        __builtin_amdgcn_sched_group_barrier(0x100, 8, 0); __builtin_amdgcn_sched_group_barrier(0x008, 4, 0);
                    }
                if (more) { const int nb2 = ((kt + 1) & 1) * 34816;
                    *(LAS u32x4*)(lds + nb2 + kd0) = pk0; *(LAS u32x4*)(lds + nb2 + kd1) = pk1;
                    *(LAS u32x2*)(lds + nb2 + vd0) = (u32x2){pv0.x, pv0.y}; *(LAS u32x2*)(lds + nb2 + vd0 + 8) = (u32x2){pv0.z, pv0.w};
                    *(LAS u32x2*)(lds + nb2 + vd1) = (u32x2){pv1.x, pv1.y}; *(LAS u32x2*)(lds + nb2 + vd1 + 8) = (u32x2){pv1.z, pv1.w}; }
                __syncthreads();
            }
            const float ltot = lrun + __shfl_xor(lrun, 32);
            const float inv = 1.0f / ltot;
            bf16_t* op = (rep_ + 1 < REP_P5 ? (bf16_t*)Z : Q) + (size_t)mq * DM + hq * 128 + 4 * h;
#pragma unroll
            for (int dt = 0; dt < 4; ++dt)
#pragma unroll
                for (int g4 = 0; g4 < 4; ++g4) {
                    u32x2 w; w.x = cvt_pk_bf16(o[dt][4 * g4 + 0] * inv, o[dt][4 * g4 + 1] * inv); w.y = cvt_pk_bf16(o[dt][4 * g4 + 2] * inv, o[dt][4 * g4 + 3] * inv);
                    *(u32x2*)(op + 32 * dt + 8 * g4) = w; }
        }
    }
    xcd_barrier(xbar);
    }

    {
        pg8::StaticOrder S; S.init(MT, DM, G, bx);
        { pg8::Gemm g{CB, WA_T, MT, DM, DM}; EpiGate1 E{GA, TMP}; pg8::gemm_phase<EpiGate1>(lds, g, S, E); }
        { pg8::Gemm g{Q, WB_T, MT, DM, DM}; EpiGate2 E{GB, TMP, U}; pg8::gemm_phase<EpiGate2>(lds, g, S, E); }
    }
    xcd_barrier(xbar);

    {
        pg8::Gemm g{U, WO_T, MT, DM, DM}; pg8::StaticOrder S; S.init(MT, DM, G, bx);
        EpiRes E{x, MOD + 2 * DM, Z};
        pg8::gemm_phase<EpiRes>(lds, g, S, E);
    }
    xcd_barrier(xbar);

    for (int m = gw; m < MT; m += NGW) {
        const int b = m >> 12;
        const float* zr = Z + (size_t)m * DM;
        f32x4 v[8]; float s = 0.f;
#pragma unroll
        for (int j = 0; j < 8; ++j) { v[j] = *(const f32x4*)(zr + j * 256 + lane * 4); s += (v[j][0] + v[j][1]) + (v[j][2] + v[j][3]); }
        const float mu = wave_sum(s) * (1.0f / DM); float s2 = 0.f;
#pragma unroll
        for (int j = 0; j < 8; ++j) { v[j] = v[j] - mu; s2 += (v[j][0] * v[j][0] + v[j][1] * v[j][1]) + (v[j][2] * v[j][2] + v[j][3] * v[j][3]); }
        const float rstd = rsqrtf(wave_sum(s2) * (1.0f / DM) + LN_EPS);
        const float* shf = MOD + (size_t)b * NMOD + 3 * DM; const float* scf = MOD + (size_t)b * NMOD + 4 * DM;
#pragma unroll
        for (int j = 0; j < 8; ++j) { const int col = j * 256 + lane * 4;
            const f32x4 gg = *(const f32x4*)(ln1_g + col), bb = *(const f32x4*)(ln1_b + col), sc4 = *(const f32x4*)(scf + col), sh4 = *(const f32x4*)(shf + col);
            f32x4 y, uu;
#pragma unroll
            for (int k = 0; k < 4; ++k) { y[k] = v[j][k] * rstd * gg[k] + bb[k]; uu[k] = y[k] * (1.0f + sc4[k]) + sh4[k]; }
            *(f32x4*)(X1 + (size_t)m * DM + col) = y;
            u32x2 w; w.x = cvt_pk_bf16(uu[0], uu[1]); w.y = cvt_pk_bf16(uu[2], uu[3]);
            *(u32x2*)(U + (size_t)m * DM + col) = w; }
    }
    xcd_barrier(xbar);

    {
        pg8::Gemm g{U, WUP_T, MT, 2 * DFF, DM}; pg8::StaticOrder S; S.init(MT, 2 * DFF, G, bx);
        EpiUp E{HG, SA, SG, conv_f};
        pg8::gemm_phase<EpiUp>(lds, g, S, E);
    }
    xcd_barrier(xbar);

    for (int un = gtid; un < 256 * (DFF / 4); un += NGT) {
        const int c4 = (un % (DFF / 4)) * 4, br = un / (DFF / 4), gi = br >> 1, lo = br & 1, row = gi * 64 + lo, t = row & (SEQ - 1);
        const f32x4 s0 = *(const f32x4*)(SA + ((size_t)(gi * 4 + 0)) * DFF + c4), s1 = *(const f32x4*)(SA + ((size_t)(gi * 4 + 1)) * DFF + c4),
                    s2 = *(const f32x4*)(SA + ((size_t)(gi * 4 + 2)) * DFF + c4), s3 = *(const f32x4*)(SA + ((size_t)(gi * 4 + 3)) * DFF + c4);
        const f32x4 gt = *(const f32x4*)(SG + ((size_t)(gi * 2 + lo)) * DFF + c4);
        const f32x4 w0 = *(const f32x4*)(conv_f + c4), w1 = *(const f32x4*)(conv_f + DFF + c4), w2 = *(const f32x4*)(conv_f + 2 * DFF + c4);
        float y[4];
#pragma unroll
        for (int j = 0; j < 4; ++j) {
            const float a0 = lo ? s3[j] : s2[j];
            float a1 = lo ? s2[j] : s1[j], a2 = lo ? s1[j] : s0[j];
            if (t < 1) a1 = 0.f;
            if (t < 2) a2 = 0.f;
            y[j] = gelu_tanh_(w0[j] * a2 + w1[j] * a1 + w2[j] * a0) * gt[j];
        }
        u32x2 w; w.x = cvt_pk_bf16(y[0], y[1]); w.y = cvt_pk_bf16(y[2], y[3]);
        *(u32x2*)(HG + (size_t)row * DFF + c4) = w;
    }
    xcd_barrier(xbar);

    {
        pg8::Gemm g{HG, WD_T, MT, DM, DFF}; pg8::StaticOrder S; S.init(MT, DM, G, bx);
        EpiRes E{X1, MOD + 5 * DM, Z2};
        pg8::gemm_phase<EpiRes>(lds, g, S, E);
    }
    xcd_barrier(xbar);

    for (int m = gw; m < MT; m += NGW) {
        const float* zr = Z2 + (size_t)m * DM;
        f32x4 v[8]; float s = 0.f;
#pragma unroll
        for (int j = 0; j < 8; ++j) { v[j] = *(const f32x4*)(zr + j * 256 + lane * 4); s += (v[j][0] + v[j][1]) + (v[j][2] + v[j][3]); }
        const float mu = wave_sum(s) * (1.0f / DM); float s2 = 0.f;
#pragma unroll
        for (int j = 0; j < 8; ++j) { v[j] = v[j] - mu; s2 += (v[j][0] * v[j][0] + v[j][1] * v[j][1]) + (v[j][2] * v[j][2] + v[j][3] * v[j][3]); }
        const float rstd = rsqrtf(wave_sum(s2) * (1.0f / DM) + LN_EPS);
#pragma unroll
        for (int j = 0; j < 8; ++j) { const int col = j * 256 + lane * 4;
            const f32x4 gg = *(const f32x4*)(ln2_g + col), bb = *(const f32x4*)(ln2_b + col);
            f32x4 y;
#pragma unroll
            for (int k = 0; k < 4; ++k) y[k] = v[j][k] * rstd * gg[k] + bb[k];
            *(f32x4*)(out + (size_t)m * DM + col) = y; }
    }
}

extern "C" void kernel_launch(void* const* d_in, const int* in_sizes, int n_in, void* d_out, int out_size, void* d_ws, size_t ws_size, hipStream_t stream) {
    static int grid_blocks = 0;
    if (grid_blocks == 0) {
        if (n_in != 18 || ws_size < WS_END) { fprintf(stderr, "kernel_launch: unexpected n_in %d or ws_size %zu (< %zu)\n", n_in, ws_size, (size_t)WS_END); grid_blocks = -1; return; }
        int dev = 0, cus = 0, per_cu = 0;
        hipGetDevice(&dev);
        hipDeviceGetAttribute(&cus, hipDeviceAttributeMultiprocessorCount, dev);
        if (hipFuncSetAttribute((const void*)fwd_megakernel, hipFuncAttributeMaxDynamicSharedMemorySize, LDS_BYTES) != hipSuccess) { fprintf(stderr, "kernel_launch: hipFuncSetAttribute failed\n"); grid_blocks = -1; return; }
        hipOccupancyMaxActiveBlocksPerMultiprocessor(&per_cu, (const void*)fwd_megakernel, NTHR, LDS_BYTES);
        if (per_cu < 1) { fprintf(stderr, "kernel_launch: occupancy query says %d\n", per_cu); per_cu = 1; }
        (void)hipGetLastError();
        grid_blocks = cus * per_cu;
    }
    if (grid_blocks < 0) return;
    Args a{};
    for (int i = 0; i < 18; ++i) a.in[i] = (const float*)d_in[i];
    a.out = (float*)d_out; a.ws = (unsigned char*)d_ws;
    void* kargs[] = {&a};
    hipError_t e = hipLaunchCooperativeKernel((const void*)fwd_megakernel, dim3(grid_blocks), dim3(NTHR), kargs, LDS_BYTES, stream);
    if (e != hipSuccess) fprintf(stderr, "cooperative launch failed: %s (grid %d)\n", hipGetErrorString(e), grid_blocks);
}
```

```cpp
#include <hip/hip_runtime.h>
#include <hip/hip_cooperative_groups.h>
#include <cstdio>
namespace cg = cooperative_groups;

#define LAS __attribute__((address_space(3)))
typedef unsigned short bf16_t;
typedef short bf16x8 __attribute__((ext_vector_type(8)));
typedef float f32x4 __attribute__((ext_vector_type(4)));
typedef float f32x16 __attribute__((ext_vector_type(16)));
typedef unsigned u32x4 __attribute__((ext_vector_type(4)));
typedef unsigned u32x2 __attribute__((ext_vector_type(2)));

#ifndef REP_P0
#define REP_P0 1
#endif
#ifndef REP_P1
#define REP_P1 1
#endif
#ifndef REP_P4
#define REP_P4 1
#endif
#ifndef REP_P4B
#define REP_P4B 1
#endif
#ifndef REP_P5
#define REP_P5 1
#endif
constexpr int NB = 2, SEQ = 4096, DM = 2048, MT = NB * SEQ;
constexpr int NPROJ = 14592;
constexpr int DFF = 5632, NMOD = 12288;
constexpr float ALPHA = 1.189207115002721f;
constexpr float LN_EPS = 1e-5f;
constexpr int NWAVES = 8, NTHR = 512;
constexpr int LDS_BYTES = 147456;

constexpr size_t al256(size_t x) { return (x + 255) & ~(size_t)255; }
constexpr size_t WS_PART = 1u << 20;
constexpr size_t WS_MOD  = WS_PART + al256((size_t)8 * 2 * NMOD * 4);
constexpr size_t ACT     = (size_t)MT * DM * 2;
constexpr size_t WS_WA   = WS_MOD + al256((size_t)2 * NMOD * 4);
constexpr size_t WS_WB   = WS_WA + (size_t)DM * DM * 2;
constexpr size_t WS_WO   = WS_WB + (size_t)DM * DM * 2;
constexpr size_t WS_WUP  = WS_WO + (size_t)DM * DM * 2;
constexpr size_t WS_WD   = WS_WUP + (size_t)2 * DFF * DM * 2;
constexpr size_t WS_WIN  = WS_WD + (size_t)DM * DFF * 2;
constexpr size_t WS_U    = WS_WIN + (size_t)NPROJ * DM * 2;
constexpr size_t WS_CC   = WS_U + ACT;
constexpr size_t WS_CH   = WS_CC + ACT;
constexpr size_t WS_CB   = WS_CH + ACT;
constexpr size_t WS_Q    = WS_CB + ACT;
constexpr size_t WS_GA   = WS_Q + ACT;
constexpr size_t WS_GB   = WS_GA + ACT;
constexpr size_t WS_K    = WS_GB + ACT;
constexpr size_t WS_V    = WS_K + (size_t)MT * 512 * 2;
constexpr size_t WS_VT   = WS_V + (size_t)MT * 512 * 2;
constexpr size_t WS_QI   = WS_VT + (size_t)MT * 512 * 2;
constexpr size_t WS_KW   = WS_QI + (size_t)MT * 1024 * 2;
constexpr size_t WS_KIB  = WS_KW + (size_t)MT * 256 * 2;
constexpr size_t WS_WIF  = WS_KIB + (size_t)MT * 64 * 2;
constexpr size_t WS_MASK = WS_WIF + (size_t)MT * 16 * 4;
constexpr size_t WS_END  = WS_MASK + (size_t)MT * 64 * 8;
constexpr size_t WS_SCB  = WS_WIN;
constexpr size_t WS_Z    = WS_CC;
constexpr size_t WS_HA   = WS_CC;
constexpr size_t WS_HG   = WS_CC + (size_t)MT * DFF * 2;
constexpr size_t WS_Z2   = WS_CC;
static_assert(WS_HG + (size_t)MT * DFF * 2 <= WS_K, "up-proj overlay fits in the proj region");
static_assert(WS_SCB + (size_t)MT * SEQ * 4 <= WS_CB, "score buffer fits in WIN|U|CC|CH");

__device__ __forceinline__ unsigned cvt_pk_bf16(float lo, float hi) { unsigned r; asm volatile("v_cvt_pk_bf16_f32 %0, %1, %2" : "=v"(r) : "v"(lo), "v"(hi)); return r; }
__device__ __forceinline__ float bflo(unsigned w) { return __uint_as_float(w << 16); }
__device__ __forceinline__ float bfhi(unsigned w) { return __uint_as_float(w & 0xffff0000u); }
__device__ __forceinline__ float sigmoidf_(float g) { return __builtin_amdgcn_rcpf(1.0f + __expf(-g)); }
__device__ __forceinline__ float wave_sum(float v) {
#pragma unroll
    for (int o = 1; o < 64; o <<= 1) v += __shfl_xor(v, o);
    return v;
}

namespace pg8 {
constexpr int BM = 256, BK = 64, HALF = 128, HTB = HALF * BK * 2, STAGE_BYTES = 8 * HTB, NXCD = 8, WGM = 8;
__host__ __device__ __forceinline__ int lds_byte(int r, int c) { const int st = (r >> 4) * 2 + (c >> 5), rr = r & 15, cc = c & 31, ob = rr * 64 + cc * 2; return st * 1024 + (ob ^ (((ob >> 9) & 1) << 5)); }
__host__ __device__ __forceinline__ void stage_rc(int b, int& R, int& C) { const int st = b / 1024, sb = b % 1024, swz = sb ^ (((sb >> 9) & 1) << 5); R = (st >> 1) * 16 + swz / 64; C = (st & 1) * 32 + (swz % 64) / 2; }
__host__ __device__ __forceinline__ int perm32(int rho) { const int n = rho >> 4, i = rho & 15; return 8 * (i >> 2) + 4 * n + (i & 3); }
struct Unit { int pm, pn; };
struct Gemm { const bf16_t* A; const bf16_t* Bt; int M, N, K; const bf16_t* A2; const bf16_t* Bt2; };
struct StaticOrder {
    int nM, nN, nwg, G, c;
    __host__ __device__ void init(int M, int N, int G_, int c_) { nM = M / BM; nN = N / BM; nwg = nM * nN; G = G_; c = c_; }
    __host__ __device__ bool next(int i, Unit& u) const {
        const long L = (long)i * G + c; if (L >= nwg) return false;
        int wgid = (int)L; { const int q = nwg / NXCD, r = nwg % NXCD, xcd = wgid % NXCD, off = wgid / NXCD; wgid = (xcd < r ? xcd * (q + 1) : r * (q + 1) + (xcd - r) * q) + off; }
        const int nig = WGM * nN, gid = wgid / nig, fm = gid * WGM, gsz = (nM - fm) < WGM ? (nM - fm) : WGM;
        u.pm = fm + ((wgid % nig) % gsz); u.pn = (wgid % nig) / gsz; return true;
    }
};
template <class Epi, bool TWO = false>
__device__ __forceinline__ void gemm_phase(LAS unsigned char* lds, const Gemm g, const StaticOrder& S, const Epi& E) {
    const int tid = threadIdx.x, wid = __builtin_amdgcn_readfirstlane(tid >> 6), lane = tid & 63, wr = wid >> 2, wc = wid & 3, fr = lane & 15, fq = lane >> 4;
    const int K = g.K, nt = K / BK;
    unsigned voffA[2], voffB[2];
#pragma unroll
    for (int i = 0; i < 2; ++i) { int R, C; stage_rc(tid * 16 + i * 8192, R, C); const int Rb = (R & ~31) + perm32(R & 31);
        voffA[i] = (unsigned)(R * K + C) * 2u; voffB[i] = (unsigned)(Rb * K + C) * 2u; }
    const size_t kstep = (size_t)(BK * 2);
    const size_t hstep = (size_t)HALF * K * 2;
    const size_t tstep = 2 * hstep;
    const unsigned ldsw = (unsigned)wid * 1024u;
    const int aoff = lds_byte(wr * 64 + fr, fq * 8), boff = lds_byte(wc * 32 + fr, fq * 8);
#define PG8_SA(b, h) (((b) * 2 + (h)) * HTB)
#define PG8_SB(b, h) ((4 + (b) * 2 + (h)) * HTB)
#define PG8_STAGE(bufoff, gbase, voff) do { _Pragma("unroll") for (int _i = 0; _i < 2; ++_i) \
        __builtin_amdgcn_global_load_lds((const unsigned*)((const char*)(gbase) + (voff)[_i]), (LAS unsigned*)(lds + (bufoff) + ldsw + _i * 8192), 16, 0, 0); } while (0)
#define PG8_LDA(dst, b, h) do { _Pragma("unroll") for (int m = 0; m < 4; ++m) _Pragma("unroll") for (int k = 0; k < 2; ++k) dst[m][k] = *(const LAS bf16x8*)(lds + PG8_SA(b, h) + aoff + m * 2048 + k * 1024); } while (0)
#define PG8_LDB(dst, b, h) do { _Pragma("unroll") for (int n = 0; n < 2; ++n) _Pragma("unroll") for (int k = 0; k < 2; ++k) dst[n][k] = *(const LAS bf16x8*)(lds + PG8_SB(b, h) + boff + n * 2048 + k * 1024); } while (0)
#define PG8_MMA(ai, bj, At, Bt) do { __builtin_amdgcn_s_setprio(1); _Pragma("unroll") for (int m = 0; m < 4; ++m) _Pragma("unroll") for (int n = 0; n < 2; ++n) _Pragma("unroll") for (int k = 0; k < 2; ++k) \
        acc[ai][bj][m][n] = __builtin_amdgcn_mfma_f32_16x16x32_bf16(Bt[n][k], At[m][k], acc[ai][bj][m][n], 0, 0, 0); __builtin_amdgcn_s_setprio(0); } while (0)
#define PG8_WAIT_V(n) asm volatile("s_waitcnt vmcnt(" #n ")" ::: "memory")
#define PG8_WAIT_L(n) asm volatile("s_waitcnt lgkmcnt(" #n ")" ::: "memory")
#define PG8_BAR __builtin_amdgcn_s_barrier()
#define PG8_SCHED __builtin_amdgcn_sched_barrier(0)
    Unit cur, nxt; int ui = 0, cst = 0;
    if (!S.next(0, cur)) return;
    f32x4 acc[2][2][4][2];
#pragma unroll
    for (int a = 0; a < 2; ++a)
#pragma unroll
        for (int b = 0; b < 2; ++b)
#pragma unroll
            for (int m = 0; m < 4; ++m)
#pragma unroll
                for (int n = 0; n < 2; ++n) acc[a][b][m][n] = (f32x4){0.f, 0.f, 0.f, 0.f};
    bf16x8 At[4][2], B0[2][2], B1[2][2];
    const char* cA = (const char*)g.A + (size_t)cur.pm * tstep; const char* cB = (const char*)g.Bt + (size_t)cur.pn * tstep;
    PG8_STAGE(PG8_SB(0, 0), cB, voffB); PG8_STAGE(PG8_SA(0, 0), cA, voffA); PG8_STAGE(PG8_SB(0, 1), cB + hstep, voffB); PG8_STAGE(PG8_SA(0, 1), cA + hstep, voffA);
    if (wr == 1) PG8_BAR;
    PG8_WAIT_V(4); PG8_BAR;
    PG8_STAGE(PG8_SB(1, 0), cB + kstep, voffB); PG8_STAGE(PG8_SA(1, 0), cA + kstep, voffA); PG8_STAGE(PG8_SB(1, 1), cB + hstep + kstep, voffB);
    PG8_WAIT_V(6); PG8_BAR;
    for (;;) {
        bool has_next; int nst = 0;
        if (TWO && cst == 0) { has_next = true; nxt = cur; nst = 1; } else has_next = S.next(ui + 1, nxt);
        const char* nA = has_next ? (const char*)((TWO && nst) ? g.A2 : g.A) + (size_t)nxt.pm * tstep : cA;
        const char* nB = has_next ? (const char*)((TWO && nst) ? g.Bt2 : g.Bt) + (size_t)nxt.pn * tstep : cB;
        for (int t = 0; t < nt; t += 2) {
            const bool last = (t == nt - 2);
            const char* a1 = cA + (size_t)(t + 1) * kstep;
            const char* a2 = last ? nA : cA + (size_t)(t + 2) * kstep; const char* b2 = last ? nB : cB + (size_t)(t + 2) * kstep;
            const char* a3 = a2 + kstep; const char* b3 = b2 + kstep;
            PG8_LDB(B0, 0, 0); PG8_SCHED; PG8_LDA(At, 0, 0); PG8_STAGE(PG8_SA(1, 1), a1 + hstep, voffA);
            PG8_WAIT_L(8); PG8_BAR; PG8_WAIT_L(0); PG8_MMA(0, 0, At, B0); PG8_BAR; PG8_SCHED;
            PG8_LDB(B1, 0, 1); PG8_STAGE(PG8_SB(0, 0), b2, voffB);
            PG8_BAR; PG8_WAIT_L(0); PG8_MMA(0, 1, At, B1); PG8_BAR;
            PG8_LDA(At, 0, 1); PG8_STAGE(PG8_SA(0, 0), a2, voffA);
            PG8_BAR; PG8_WAIT_L(0); PG8_MMA(1, 0, At, B0); PG8_BAR; PG8_SCHED;
            PG8_STAGE(PG8_SB(0, 1), b2 + hstep, voffB);
            PG8_WAIT_V(6); PG8_BAR; PG8_MMA(1, 1, At, B1); PG8_BAR;
            PG8_LDB(B0, 1, 0); PG8_SCHED; PG8_LDA(At, 1, 0); PG8_STAGE(PG8_SA(0, 1), a2 + hstep, voffA);
            PG8_WAIT_L(8); PG8_BAR; PG8_WAIT_L(0); PG8_MMA(0, 0, At, B0); PG8_BAR; PG8_SCHED;
            PG8_LDB(B1, 1, 1); PG8_STAGE(PG8_SB(1, 0), b3, voffB);
            PG8_BAR; PG8_WAIT_L(0); PG8_MMA(0, 1, At, B1); PG8_BAR;
            PG8_LDA(At, 1, 1); PG8_STAGE(PG8_SA(1, 0), a3, voffA);
            PG8_BAR; PG8_WAIT_L(0); PG8_MMA(1, 0, At, B0); PG8_BAR; PG8_SCHED;
            PG8_STAGE(PG8_SB(1, 1), b3 + hstep, voffB);
            PG8_WAIT_V(6); PG8_BAR; PG8_MMA(1, 1, At, B1); PG8_BAR;
        }
        if constexpr (TWO) { if (cst == 0) E.mid(acc, cur, wr, wc, fr, fq); else E(acc, cur, wr, wc, fr, fq); }
        else E(acc, cur, wr, wc, fr, fq);
        if (!has_next) break;
        if (!(TWO && cst == 0)) {
#pragma unroll
        for (int a = 0; a < 2; ++a)
#pragma unroll
            for (int b = 0; b < 2; ++b)
#pragma unroll
                for (int m = 0; m < 4; ++m)
#pragma unroll
                    for (int n = 0; n < 2; ++n) acc[a][b][m][n] = (f32x4){0.f, 0.f, 0.f, 0.f};
        }
        cur = nxt; cA = nA; cB = nB;
        if (TWO) { if (cst == 1) ++ui; cst = nst; } else ++ui;
    }
    PG8_WAIT_V(0);
    if (wr == 0) PG8_BAR;
    PG8_BAR;
#undef PG8_SA
#undef PG8_SB
#undef PG8_STAGE
#undef PG8_LDA
#undef PG8_LDB
#undef PG8_MMA
#undef PG8_WAIT_V
#undef PG8_WAIT_L
#undef PG8_BAR
#undef PG8_SCHED
}
}

typedef f32x4 AccT[2][2][4][2];
#define EPI_LOOP_BEGIN \
    _Pragma("unroll") for (int ai = 0; ai < 2; ++ai) _Pragma("unroll") for (int m = 0; m < 4; ++m) { \
        const int row = u.pm * 256 + ai * 128 + wr * 64 + m * 16 + fr; \
        _Pragma("unroll") for (int bj = 0; bj < 2; ++bj) { const int ct = bj * 128 + wc * 32 + 8 * fq;   \
            const f32x4 v0 = acc[ai][bj][m][0], v1 = acc[ai][bj][m][1];
#define EPI_LOOP_END } }

struct EpiProj {
    unsigned char* ws;
    __device__ __forceinline__ void operator()(const AccT& acc, const pg8::Unit& u, int wr, int wc, int fr, int fq) const {
        const int pn = u.pn; bf16_t* base; int ld, c0;
        if (pn < 8)       { base = (bf16_t*)(ws + WS_CB); ld = 2048; c0 = pn * 256; }
        else if (pn < 16) { base = (bf16_t*)(ws + WS_CC); ld = 2048; c0 = (pn - 8) * 256; }
        else if (pn < 24) { base = (bf16_t*)(ws + WS_CH); ld = 2048; c0 = (pn - 16) * 256; }
        else if (pn < 32) { base = (bf16_t*)(ws + WS_Q);  ld = 2048; c0 = (pn - 24) * 256; }
        else if (pn < 34) { base = (bf16_t*)(ws + WS_K);  ld = 512;  c0 = (pn - 32) * 256; }
        else if (pn < 36) { base = (bf16_t*)(ws + WS_V);  ld = 512;  c0 = (pn - 34) * 256; }
        else if (pn < 40) { base = (bf16_t*)(ws + WS_QI); ld = 1024; c0 = (pn - 36) * 256; }
        else if (pn < 48) { base = (bf16_t*)(ws + WS_GA); ld = 2048; c0 = (pn - 40) * 256; }
        else if (pn < 56) { base = (bf16_t*)(ws + WS_GB); ld = 2048; c0 = (pn - 48) * 256; }
        else              { base = (bf16_t*)(ws + WS_KW); ld = 256;  c0 = 0; }
        EPI_LOOP_BEGIN
            u32x4 w; w.x = cvt_pk_bf16(v0[0], v0[1]); w.y = cvt_pk_bf16(v0[2], v0[3]); w.z = cvt_pk_bf16(v1[0], v1[1]); w.w = cvt_pk_bf16(v1[2], v1[3]);
            *(u32x4*)(base + (size_t)row * ld + c0 + ct) = w;
        EPI_LOOP_END
    }
};
__device__ __forceinline__ float dpp_ror1(float x) { return __builtin_bit_cast(float, __builtin_amdgcn_update_dpp(0, __builtin_bit_cast(int, x), 0x121, 0xf, 0xf, false)); }
__device__ __forceinline__ float dpp_ror2(float x) { return __builtin_bit_cast(float, __builtin_amdgcn_update_dpp(0, __builtin_bit_cast(int, x), 0x122, 0xf, 0xf, false)); }
__device__ __forceinline__ float gelu_tanh_(float v) { const float inner = 0.7978845608028654f * (v + 0.044715f * v * v * v); return v * __builtin_amdgcn_rcpf(1.0f + __expf(-2.0f * inner)); }
struct EpiUp {
    bf16_t* HH; float* SA  ; float* SG  ; const float* cw  ;
    __device__ __forceinline__ void operator()(const AccT& acc, const pg8::Unit& u, int wr, int wc, int fr, int fq) const {
        const int c0 = u.pn * 128 + wc * 32 + 8 * fq;
        float w0[8], w1[8], w2[8];
        { const f32x4 a = *(const f32x4*)(cw + c0), b = *(const f32x4*)(cw + c0 + 4), c = *(const f32x4*)(cw + DFF + c0), d = *(const f32x4*)(cw + DFF + c0 + 4),
                      e = *(const f32x4*)(cw + 2 * DFF + c0), f = *(const f32x4*)(cw + 2 * DFF + c0 + 4);
#pragma unroll
          for (int j = 0; j < 4; ++j) { w0[j] = a[j]; w0[4 + j] = b[j]; w1[j] = c[j]; w1[4 + j] = d[j]; w2[j] = e[j]; w2[4 + j] = f[j]; } }
#pragma unroll
        for (int ai = 0; ai < 2; ++ai) {
            float pr1[8], pr2[8];
#pragma unroll
            for (int e = 0; e < 8; ++e) { pr1[e] = 0.f; pr2[e] = 0.f; }
#pragma unroll
            for (int m = 0; m < 4; ++m) {
                const int row = u.pm * 256 + ai * 128 + wr * 64 + m * 16 + fr;
                float y[8];
#pragma unroll
                for (int e = 0; e < 8; ++e) {
                    const float a = acc[ai][0][m][e >> 2][e & 3], g = acc[ai][1][m][e >> 2][e & 3];
                    const float r1 = dpp_ror1(a), r2 = dpp_ror2(a);
                    const float p1 = (fr >= 1) ? r1 : pr1[e], p2 = (fr >= 2) ? r2 : pr2[e];
                    pr1[e] = r1; pr2[e] = r2;
                    y[e] = gelu_tanh_(w0[e] * p2 + w1[e] * p1 + w2[e] * a) * g;
                }
                u32x4 w; w.x = cvt_pk_bf16(y[0], y[1]); w.y = cvt_pk_bf16(y[2], y[3]); w.z = cvt_pk_bf16(y[4], y[5]); w.w = cvt_pk_bf16(y[6], y[7]);
                *(u32x4*)(HH + (size_t)row * DFF + c0) = w;
                if (m == 0 && fr < 2) {
                    const int gi = row >> 6;
                    float* sa = SA + ((size_t)(gi * 4 + 2 + fr)) * DFF + c0; float* sg = SG + ((size_t)(gi * 2 + fr)) * DFF + c0;
                    *(f32x4*)(sa) = acc[ai][0][m][0]; *(f32x4*)(sa + 4) = acc[ai][0][m][1]; *(f32x4*)(sg) = acc[ai][1][m][0]; *(f32x4*)(sg + 4) = acc[ai][1][m][1];
                }
                if (m == 3 && fr >= 14) {
                    const int gi = (row >> 6) + 1;
                    float* sa = SA + ((size_t)(gi * 4 + (fr - 14))) * DFF + c0;
                    *(f32x4*)(sa) = acc[ai][0][m][0]; *(f32x4*)(sa + 4) = acc[ai][0][m][1];
                }
            }
        }
    }
};
struct EpiGate1 {
    const bf16_t* G; float* TMP;
    __device__ __forceinline__ void operator()(const AccT& acc, const pg8::Unit& u, int wr, int wc, int fr, int fq) const {
        EPI_LOOP_BEGIN
            const size_t off = (size_t)row * DM + u.pn * 256 + ct;
            const u32x4 g = *(const u32x4*)(G + off);
            f32x4 o0, o1;
            o0[0] = sigmoidf_(bflo(g.x)) * v0[0]; o0[1] = sigmoidf_(bfhi(g.x)) * v0[1]; o0[2] = sigmoidf_(bflo(g.y)) * v0[2]; o0[3] = sigmoidf_(bfhi(g.y)) * v0[3];
            o1[0] = sigmoidf_(bflo(g.z)) * v1[0]; o1[1] = sigmoidf_(bfhi(g.z)) * v1[1]; o1[2] = sigmoidf_(bflo(g.w)) * v1[2]; o1[3] = sigmoidf_(bfhi(g.w)) * v1[3];
            *(f32x4*)(TMP + off) = o0; *(f32x4*)(TMP + off + 4) = o1;
        EPI_LOOP_END
    }
};
struct EpiGate2 {
    const bf16_t* G; const float* TMP; bf16_t* OUT;
    __device__ __forceinline__ void operator()(const AccT& acc, const pg8::Unit& u, int wr, int wc, int fr, int fq) const {
        EPI_LOOP_BEGIN
            const size_t off = (size_t)row * DM + u.pn * 256 + ct;
            const u32x4 g = *(const u32x4*)(G + off);
            const f32x4 t0 = *(const f32x4*)(TMP + off), t1 = *(const f32x4*)(TMP + off + 4);
            f32x4 o0, o1;
            o0[0] = t0[0] + sigmoidf_(bflo(g.x)) * v0[0]; o0[1] = t0[1] + sigmoidf_(bfhi(g.x)) * v0[1]; o0[2] = t0[2] + sigmoidf_(bflo(g.y)) * v0[2]; o0[3] = t0[3] + sigmoidf_(bfhi(g.y)) * v0[3];
            o1[0] = t1[0] + sigmoidf_(bflo(g.z)) * v1[0]; o1[1] = t1[1] + sigmoidf_(bfhi(g.z)) * v1[1]; o1[2] = t1[2] + sigmoidf_(bflo(g.w)) * v1[2]; o1[3] = t1[3] + sigmoidf_(bfhi(g.w)) * v1[3];
            u32x4 w; w.x = cvt_pk_bf16(o0[0], o0[1]); w.y = cvt_pk_bf16(o0[2], o0[3]); w.z = cvt_pk_bf16(o1[0], o1[1]); w.w = cvt_pk_bf16(o1[2], o1[3]);
            *(u32x4*)(OUT + off) = w;
        EPI_LOOP_END
    }
};
struct EpiMerged {
    const bf16_t* Ga; const bf16_t* Gb; bf16_t* OUT;
    __device__ __forceinline__ void mid(AccT& acc, const pg8::Unit& u, int wr, int wc, int fr, int fq) const {
#pragma unroll
        for (int ai = 0; ai < 2; ++ai)
#pragma unroll
            for (int m = 0; m < 4; ++m) { const int row = u.pm * 256 + ai * 128 + wr * 64 + m * 16 + fr;
#pragma unroll
                for (int bj = 0; bj < 2; ++bj) { const size_t off = (size_t)row * DM + u.pn * 256 + bj * 128 + wc * 32 + 8 * fq;
                    const u32x4 ga = *(const u32x4*)(Ga + off), gb = *(const u32x4*)(Gb + off);
#pragma unroll
                    for (int k = 0; k < 4; ++k) {
                        const float a0 = bflo(ga[k]), a1 = bfhi(ga[k]), b0 = bflo(gb[k]), b1 = bfhi(gb[k]);
                        const float r0 = (1.0f + __expf(-b0)) * __builtin_amdgcn_rcpf(1.0f + __expf(-a0)), r1 = (1.0f + __expf(-b1)) * __builtin_amdgcn_rcpf(1.0f + __expf(-a1));
                        acc[ai][bj][m][k >> 1][(k & 1) * 2] *= r0; acc[ai][bj][m][k >> 1][(k & 1) * 2 + 1] *= r1;
                    } } }
    }
    __device__ __forceinline__ void operator()(const AccT& acc, const pg8::Unit& u, int wr, int wc, int fr, int fq) const {
        EPI_LOOP_BEGIN
            const size_t off = (size_t)row * DM + u.pn * 256 + ct;
            const u32x4 g = *(const u32x4*)(Gb + off);
            u32x4 w; w.x = cvt_pk_bf16(sigmoidf_(bflo(g.x)) * v0[0], sigmoidf_(bfhi(g.x)) * v0[1]); w.y = cvt_pk_bf16(sigmoidf_(bflo(g.y)) * v0[2], sigmoidf_(bfhi(g.y)) * v0[3]);
            w.z = cvt_pk_bf16(sigmoidf_(bflo(g.z)) * v1[0], sigmoidf_(bfhi(g.z)) * v1[1]); w.w = cvt_pk_bf16(sigmoidf_(bflo(g.w)) * v1[2], sigmoidf_(bfhi(g.w)) * v1[3]);
            *(u32x4*)(OUT + off) = w;
        EPI_LOOP_END
    }
};
struct EpiRes {
    const float* X; const float* gmod  ; float* Z;
    __device__ __forceinline__ void operator()(const AccT& acc, const pg8::Unit& u, int wr, int wc, int fr, int fq) const {
        const float* gm = gmod + (u.pm >= 16 ? NMOD : 0) + u.pn * 256;
        EPI_LOOP_BEGIN
            const size_t off = (size_t)row * DM + u.pn * 256 + ct;
            const f32x4 x0 = *(const f32x4*)(X + off), x1 = *(const f32x4*)(X + off + 4);
            const f32x4 g0 = *(const f32x4*)(gm + ct), g1 = *(const f32x4*)(gm + ct + 4);
            f32x4 o0, o1;
#pragma unroll
            for (int j = 0; j < 4; ++j) { o0[j] = ALPHA * x0[j] + (1.0f + g0[j]) * v0[j]; o1[j] = ALPHA * x1[j] + (1.0f + g1[j]) * v1[j]; }
            *(f32x4*)(Z + off) = o0; *(f32x4*)(Z + off + 4) = o1;
        EPI_LOOP_END
    }
};

template <int WIN>
__device__ __forceinline__ void transpose_item(const float* W, int K, int N, int NP, bf16_t* WT, LAS unsigned* scr, int item, int lane) {
    const int nblk = NP / 64, kb = item / nblk, nb = item % nblk, k0 = 64 * kb, n0 = 64 * nb;
    const int cl = lane & 15, kr = lane >> 4;
    const int np = n0 + 4 * cl; int sc = np; bool valid = true;
    if (WIN == 2) { const int tile = np >> 8, within = np & 255; sc = (within < 128) ? (128 * tile + within) : (DFF + 128 * tile + (within - 128)); }
    if (WIN == 1) {
        if (np < 10240) sc = np;
        else if (np < 12288) sc = 10320 + (np - 10240);
        else if (np < 14336) sc = 12368 + (np - 12288);
        else if (np < 14416) sc = 10240 + (np - 14336);
        else { valid = false; sc = 0; }
    }
    const float* src = W + (size_t)(k0 + 2 * kr) * N + sc;
    f32x4 va[8], vb[8];
#pragma unroll
    for (int i = 0; i < 8; ++i) {
        va[i] = *(const f32x4*)(src + (size_t)(8 * i) * N); vb[i] = *(const f32x4*)(src + (size_t)(8 * i + 1) * N);
        if (WIN == 1 && !valid) { va[i] = (f32x4){0.f, 0.f, 0.f, 0.f}; vb[i] = va[i]; } }
#pragma unroll
    for (int i = 0; i < 8; ++i)
#pragma unroll
        for (int j = 0; j < 4; ++j) scr[(4 * i + kr) * 65 + 4 * cl + j] = cvt_pk_bf16(va[i][j], vb[i][j]);
    asm volatile("s_waitcnt lgkmcnt(0)" ::: "memory");
    const int c = lane & 7;
#pragma unroll
    for (int j = 0; j < 8; ++j) { const int n = (lane >> 3) + 8 * j; const LAS unsigned* s = scr + (4 * c) * 65 + n;
        u32x4 o; o.x = s[0]; o.y = s[65]; o.z = s[130]; o.w = s[195];
        *(u32x4*)(WT + (size_t)(n0 + n) * K + k0 + 8 * c) = o; }
    asm volatile("s_waitcnt lgkmcnt(0)" ::: "memory");
}
__device__ __forceinline__ void transpose_rest(const float* w_a, const float* w_b, const float* w_o, const float* w_up, const float* w_down,
                                               bf16_t* WA_T, bf16_t* WB_T, bf16_t* WO_T, bf16_t* WUP_T, bf16_t* WD_T, LAS unsigned* scr, int w, int nw, int lane) {
    constexpr int I_SQ = 32 * 32, I_UP = 32 * 176, I_DN = 88 * 32;
    for (int it = w; it < 3 * I_SQ + I_UP + I_DN; it += nw) {
        int r = it;
        if (r < I_SQ) { transpose_item<0>(w_a, DM, DM, DM, WA_T, scr, r, lane); continue; } r -= I_SQ;
        if (r < I_SQ) { transpose_item<0>(w_b, DM, DM, DM, WB_T, scr, r, lane); continue; } r -= I_SQ;
        if (r < I_SQ) { transpose_item<0>(w_o, DM, DM, DM, WO_T, scr, r, lane); continue; } r -= I_SQ;
        if (r < I_UP) { transpose_item<2>(w_up, DM, 2 * DFF, 2 * DFF, WUP_T, scr, r, lane); continue; } r -= I_UP;
        transpose_item<0>(w_down, DFF, DM, DM, WD_T, scr, r, lane);
    }
}

#define XB_TMO      128
#define XB_XCNT(j)  (256  + 64 * (j))
#define XB_XSUB(j)  (1280 + 64 * (j))
#define XB_XGEN(j)  (2304 + 64 * (j))
#define XB_TOP      3328
#define XB_TOPGEN   3392
#define XCD_BAR_WORDS 3456
#define XB_SPIN_CAP (1u << 20)
__device__ __forceinline__ unsigned xb_ld(unsigned* p)              { return __hip_atomic_load(p, __ATOMIC_RELAXED, __HIP_MEMORY_SCOPE_AGENT); }
__device__ __forceinline__ unsigned xb_add(unsigned* p, unsigned v) { return __hip_atomic_fetch_add(p, v, __ATOMIC_RELAXED, __HIP_MEMORY_SCOPE_AGENT); }
__device__ __forceinline__ unsigned xb_xcc_id() { return (unsigned)__builtin_amdgcn_s_getreg((3 << 11) | 20) & 0xFu; }
#define XB_SPIN(cond, bar) do { unsigned _sp = 0; while (cond) { __builtin_amdgcn_s_sleep(1); \
    if ((++_sp & 255u) == 0u) { if (xb_ld(&(bar)[XB_TMO])) break; if (_sp > XB_SPIN_CAP) { atomicAdd(&(bar)[XB_TMO], 1u); break; } } } } while (0)
struct XcdBarrier { unsigned* bar; unsigned x; volatile LAS unsigned* st; };
__device__ __forceinline__ XcdBarrier xcd_barrier_post(unsigned* bar, volatile LAS unsigned* st) {
    XcdBarrier b; b.bar = bar; b.x = xb_xcc_id(); b.st = st;
    if (threadIdx.x == 0) (void)xb_add(&bar[XB_XCNT(b.x)], 1u);
    return b;
}
__device__ __forceinline__ void xcd_barrier_complete(unsigned* bar, unsigned x, unsigned& nloc, unsigned& nx) {
    const unsigned G = gridDim.x * gridDim.y * gridDim.z;
    unsigned sum, cnt, mine, sp = 0u;
    for (;;) {
        sum = 0u; cnt = 0u; mine = 0u;
#pragma unroll
        for (unsigned j = 0; j < 16; ++j) { const unsigned c = xb_ld(&bar[XB_XCNT(j)]); sum += c; cnt += (c > 0u) ? 1u : 0u; mine = (j == x) ? c : mine; }
        if (sum == G) break;
        __builtin_amdgcn_s_sleep(1);
        if ((++sp & 255u) == 0u) { if (xb_ld(&bar[XB_TMO])) break; if (sp > XB_SPIN_CAP) { atomicAdd(&bar[XB_TMO], 1u); break; } }
    }
    nloc = mine > 0u ? mine : 1u; nx = cnt > 0u ? cnt : 1u;
}
__device__ __forceinline__ void xcd_barrier(const XcdBarrier& b) {
    asm volatile("s_waitcnt vmcnt(0)" ::: "memory");
    __syncthreads();
    if (threadIdx.x == 0) {
        unsigned* bar = b.bar;
        __builtin_amdgcn_s_waitcnt(0);
        unsigned nloc = b.st[0], nx = b.st[1];
        if (nloc == 0u) { xcd_barrier_complete(bar, b.x, nloc, nx); b.st[0] = nloc; b.st[1] = nx; }
        const unsigned old = xb_add(&bar[XB_XSUB(b.x)], 1u);
        const unsigned gen = old / nloc;
        if (old + 1u == (gen + 1u) * nloc) {
            __builtin_amdgcn_fence(__ATOMIC_RELEASE, "agent");
            asm volatile("s_waitcnt vmcnt(0)" ::: "memory");
            const unsigned og = xb_add(&bar[XB_TOP], 1u);
            const unsigned tg = og / nx;
            if (og + 1u == (tg + 1u) * nx) xb_add(&bar[XB_TOPGEN], 1u);
            else XB_SPIN(xb_ld(&bar[XB_TOPGEN]) == tg, bar);
            __builtin_amdgcn_fence(__ATOMIC_ACQUIRE, "agent");
            xb_add(&bar[XB_XGEN(b.x)], 1u);
            asm volatile("s_waitcnt vmcnt(0)" ::: "memory");
        } else {
            XB_SPIN(xb_ld(&bar[XB_XGEN(b.x)]) == gen, bar);
            __builtin_amdgcn_fence(__ATOMIC_ACQUIRE, "agent");
            asm volatile("s_waitcnt vmcnt(0)" ::: "memory");
        }
    }
    __syncthreads();
}

struct Args { const float* in[18]; float* out; unsigned char* ws; };

__global__ void __launch_bounds__(NTHR, 2) fwd_megakernel(Args args) {
    extern __shared__ __attribute__((aligned(16))) unsigned char lds_raw[];
    LAS unsigned char* lds = (LAS unsigned char*)lds_raw;
    cg::grid_group grid = cg::this_grid();
    const int tid = threadIdx.x, lane = tid & 63, wave = __builtin_amdgcn_readfirstlane(tid >> 6);
    const int G = gridDim.x, bx = blockIdx.x;
    const int vcu = (G % 8 == 0) ? (bx % 8) * (G / 8) + bx / 8 : bx;
    const int gw = vcu * NWAVES + wave, NGW = G * NWAVES;
    const int gtid = vcu * NTHR + tid, NGT = G * NTHR;

    const float* x = args.in[0]; const float* cvec = args.in[1]; const float* w_cond = args.in[2]; const float* b_cond = args.in[3];
    const float* w_in = args.in[4]; const float* conv_a = args.in[5]; const float* kn_g = args.in[6]; const float* kn_b = args.in[7];
    const float* w_a = args.in[8]; const float* w_b = args.in[9]; const float* w_o = args.in[10]; const float* ln1_g = args.in[11]; const float* ln1_b = args.in[12];
    const float* w_up = args.in[13]; const float* conv_f = args.in[14]; const float* w_down = args.in[15]; const float* ln2_g = args.in[16]; const float* ln2_b = args.in[17];
    float* out = args.out; unsigned char* ws = args.ws;
    float* PART = (float*)(ws + WS_PART); float* MOD = (float*)(ws + WS_MOD);
    bf16_t* WIN_T = (bf16_t*)(ws + WS_WIN); bf16_t* WA_T = (bf16_t*)(ws + WS_WA); bf16_t* WB_T = (bf16_t*)(ws + WS_WB); bf16_t* WO_T = (bf16_t*)(ws + WS_WO);
    bf16_t* WUP_T = (bf16_t*)(ws + WS_WUP); bf16_t* WD_T = (bf16_t*)(ws + WS_WD);
    bf16_t* U = (bf16_t*)(ws + WS_U);
    bf16_t* CB = (bf16_t*)(ws + WS_CB); bf16_t* CC = (bf16_t*)(ws + WS_CC); bf16_t* CH = (bf16_t*)(ws + WS_CH); bf16_t* Q = (bf16_t*)(ws + WS_Q);
    bf16_t* GA = (bf16_t*)(ws + WS_GA); bf16_t* GB = (bf16_t*)(ws + WS_GB); bf16_t* KB = (bf16_t*)(ws + WS_K); bf16_t* VB = (bf16_t*)(ws + WS_V);
    bf16_t* VT = (bf16_t*)(ws + WS_VT); bf16_t* QI = (bf16_t*)(ws + WS_QI); bf16_t* KW = (bf16_t*)(ws + WS_KW); bf16_t* KIB = (bf16_t*)(ws + WS_KIB);
    float* WIF = (float*)(ws + WS_WIF); unsigned long long* MASK = (unsigned long long*)(ws + WS_MASK); unsigned* SCB = (unsigned*)(ws + WS_SCB);
    float* Z = (float*)(ws + WS_Z); float* Z2 = (float*)(ws + WS_Z2); bf16_t* HG = (bf16_t*)(ws + WS_HG); float* SA = (float*)(ws + WS_HA); float* SG = (float*)(ws + WS_HA + (size_t)129 * 4 * DFF * 4);
    float* X1 = out; float* TMP = out;
    unsigned* BARW = (unsigned*)ws;
    volatile LAS unsigned* bst = (volatile LAS unsigned*)(lds + 131072);
    if (tid < 2) bst[tid] = 0u;
    if (bx == 0) for (int i = tid; i < XCD_BAR_WORDS; i += NTHR) __hip_atomic_store(BARW + i, 0u, __ATOMIC_RELAXED, __HIP_MEMORY_SCOPE_AGENT);

    for (int rep_ = 0; rep_ < REP_P0; ++rep_) {
    {
        LAS float* cact = (LAS float*)lds;
        for (int i = tid; i < 2 * DM; i += NTHR) { const float c = cvec[i]; cact[i] = c / (1.0f + __expf(-c)); }
        __syncthreads();
        for (int item = gw; item < 8 * 192; item += NGW) {
            const int kc = item / 192, cb = item % 192, col = cb * 64 + (lane & 15) * 4, kq = lane >> 4;
            f32x4 a0 = {0.f, 0.f, 0.f, 0.f}, a1 = {0.f, 0.f, 0.f, 0.f};
            const float* wp = w_cond + (size_t)(kc * 256 + kq) * NMOD + col;
#pragma unroll 8
            for (int i = 0; i < 64; ++i) { const f32x4 w = *(const f32x4*)(wp + (size_t)(4 * i) * NMOD); const int k = kc * 256 + kq + 4 * i;
                const float s0 = cact[k], s1 = cact[DM + k]; a0 += s0 * w; a1 += s1 * w; }
#pragma unroll
            for (int j = 0; j < 4; ++j) { a0[j] += __shfl_xor(a0[j], 16); a0[j] += __shfl_xor(a0[j], 32); a1[j] += __shfl_xor(a1[j], 16); a1[j] += __shfl_xor(a1[j], 32); }
            if (lane < 16) { *(f32x4*)(PART + (size_t)(kc * 2 + 0) * NMOD + col) = a0; *(f32x4*)(PART + (size_t)(kc * 2 + 1) * NMOD + col) = a1; }
        }
        LAS unsigned* scr = (LAS unsigned*)(lds + 16384 + wave * 8448);
        for (int it = gw; it < 32 * (NPROJ / 64); it += NGW) transpose_item<1>(w_in, DM, 14416, NPROJ, WIN_T, scr, it, lane);
    }
    __syncthreads();
    }
    grid.sync();
    const XcdBarrier xbar = xcd_barrier_post(BARW, bst);

    for (int rep_ = 0; rep_ < REP_P1; ++rep_) {
    {
        for (int idx = gtid; idx < 2 * NMOD; idx += NGT) { const int b = idx / NMOD, e = idx % NMOD; float s = b_cond[e];
#pragma unroll
            for (int kc = 0; kc < 8; ++kc) s += PART[(size_t)(kc * 2 + b) * NMOD + e];
            MOD[idx] = s; }
        for (int rb = vcu; rb < MT / 32; rb += G) {
            const int b = rb >> 7, col = (tid & 255) * 8, r0 = rb * 32 + (tid >> 8) * 16;
            f32x4 sh0 = *(const f32x4*)(b_cond + col), sh1 = *(const f32x4*)(b_cond + col + 4), sc0 = *(const f32x4*)(b_cond + DM + col), sc1 = *(const f32x4*)(b_cond + DM + col + 4);
#pragma unroll
            for (int kc = 0; kc < 8; ++kc) { const float* p = PART + (size_t)(kc * 2 + b) * NMOD + col;
                sh0 += *(const f32x4*)(p); sh1 += *(const f32x4*)(p + 4); sc0 += *(const f32x4*)(p + DM); sc1 += *(const f32x4*)(p + DM + 4); }
#pragma unroll 4
            for (int r = 0; r < 16; ++r) { const size_t off = (size_t)(r0 + r) * DM + col;
                const f32x4 x0 = *(const f32x4*)(x + off), x1 = *(const f32x4*)(x + off + 4);
                f32x4 u0, u1;
#pragma unroll
                for (int j = 0; j < 4; ++j) { u0[j] = x0[j] * (1.0f + sc0[j]) + sh0[j]; u1[j] = x1[j] * (1.0f + sc1[j]) + sh1[j]; }
                u32x4 w; w.x = cvt_pk_bf16(u0[0], u0[1]); w.y = cvt_pk_bf16(u0[2], u0[3]); w.z = cvt_pk_bf16(u1[0], u1[1]); w.w = cvt_pk_bf16(u1[2], u1[3]);
                *(u32x4*)(U + off) = w; }
        }
    }
    xcd_barrier(xbar);
    }

    {
        pg8::Gemm g{U, WIN_T, MT, NPROJ, DM, nullptr, nullptr}; pg8::StaticOrder S; S.init(MT, NPROJ, G, bx);
        { pg8::Unit tu; const int nfull = (MT / 256) * (NPROJ / 256) - 7 * G;
          if (nfull > 0 && nfull < G && !S.next(7, tu)) { LAS unsigned* scr = (LAS unsigned*)(lds + wave * 8448);
              transpose_rest(w_a, w_b, w_o, w_up, w_down, WA_T, WB_T, WO_T, WUP_T, WD_T, scr, (bx - nfull) * NWAVES + wave, (G - nfull) * NWAVES, lane); }
          else if (!(nfull > 0 && nfull < G)) { LAS unsigned* scr = (LAS unsigned*)(lds + wave * 8448);
              transpose_rest(w_a, w_b, w_o, w_up, w_down, WA_T, WB_T, WO_T, WUP_T, WD_T, scr, gw, NGW, lane); } }
        __syncthreads();
        EpiProj E{ws};
        pg8::gemm_phase<EpiProj>(lds, g, S, E);
    }
    xcd_barrier(xbar);

    {
        for (int un = gtid; un < (MT / 16) * 256; un += NGT) {
            const int cg8 = un & 255, rb = un >> 8, col = cg8 * 8, m0 = rb * 16, t0 = m0 & (SEQ - 1);
            float w0[8], w1[8], w2[8], p1[8], p2[8];
#pragma unroll
            for (int j = 0; j < 8; ++j) { w0[j] = conv_a[col + j]; w1[j] = conv_a[DM + col + j]; w2[j] = conv_a[2 * DM + col + j]; p1[j] = 0.f; p2[j] = 0.f; }
            if (t0 != 0) {
                const u32x4 c2 = *(const u32x4*)(CC + (size_t)(m0 - 2) * DM + col), h2 = *(const u32x4*)(CH + (size_t)(m0 - 2) * DM + col);
                const u32x4 c1 = *(const u32x4*)(CC + (size_t)(m0 - 1) * DM + col), h1 = *(const u32x4*)(CH + (size_t)(m0 - 1) * DM + col);
#pragma unroll
                for (int j = 0; j < 4; ++j) { p2[2 * j] = bflo(c2[j]) * bflo(h2[j]); p2[2 * j + 1] = bfhi(c2[j]) * bfhi(h2[j]); p1[2 * j] = bflo(c1[j]) * bflo(h1[j]); p1[2 * j + 1] = bfhi(c1[j]) * bfhi(h1[j]); }
            }
#pragma unroll 4
            for (int r = 0; r < 16; ++r) { const size_t off = (size_t)(m0 + r) * DM + col;
                const u32x4 cc = *(const u32x4*)(CC + off), ch = *(const u32x4*)(CH + off), cb = *(const u32x4*)(CB + off);
                float p0[8], y[8];
#pragma unroll
                for (int j = 0; j < 4; ++j) { p0[2 * j] = bflo(cc[j]) * bflo(ch[j]); p0[2 * j + 1] = bfhi(cc[j]) * bfhi(ch[j]); }
#pragma unroll
                for (int j = 0; j < 8; ++j) { const float cv = w0[j] * p2[j] + w1[j] * p1[j] + w2[j] * p0[j]; const float cbv = (j & 1) ? bfhi(cb[j >> 1]) : bflo(cb[j >> 1]); y[j] = cbv * cv; p2[j] = p1[j]; p1[j] = p0[j]; }
                u32x4 w; w.x = cvt_pk_bf16(y[0], y[1]); w.y = cvt_pk_bf16(y[2], y[3]); w.z = cvt_pk_bf16(y[4], y[5]); w.w = cvt_pk_bf16(y[6], y[7]);
                *(u32x4*)(CB + off) = w; }
        }
        for (int un = vcu; un < NB * 4 * 64; un += G) {
            const int sb = un & 63, n = (un >> 6) & 3, b = un >> 8;
            LAS unsigned short* tl = (LAS unsigned short*)lds;
            __syncthreads();
#pragma unroll
            for (int j = 0; j < 2; ++j) { const int q = tid + 512 * j, row = q >> 4, ch = q & 15;
                const u32x4 v = *(const u32x4*)(VB + (size_t)(b * SEQ + sb * 64 + row) * 512 + n * 128 + ch * 8);
                LAS unsigned* d = (LAS unsigned*)(tl + row * 130 + ch * 8); d[0] = v.x; d[1] = v.y; d[2] = v.z; d[3] = v.w; }
            __syncthreads();
#pragma unroll
            for (int j = 0; j < 2; ++j) { const int q = tid + 512 * j, s8 = q & 7, d = q >> 3;
                unsigned e[8];
#pragma unroll
                for (int k = 0; k < 8; ++k) e[k] = tl[(s8 * 8 + k) * 130 + d];
                u32x4 w; w.x = e[0] | (e[1] << 16); w.y = e[2] | (e[3] << 16); w.z = e[4] | (e[5] << 16); w.w = e[6] | (e[7] << 16);
                *(u32x4*)(VT + ((size_t)((b * 4 + n) * 128 + d)) * SEQ + sb * 64 + s8 * 8) = w; }
        }
        __syncthreads();
        for (int m = gtid; m < MT; m += NGT) {
            float v[64]; float s = 0.f;
#pragma unroll
            for (int j = 0; j < 8; ++j) { const u32x4 w = *(const u32x4*)(KW + (size_t)m * 256 + j * 8);
#pragma unroll
                for (int k = 0; k < 4; ++k) { v[j * 8 + 2 * k] = bflo(w[k]); v[j * 8 + 2 * k + 1] = bfhi(w[k]); } }
#pragma unroll
            for (int j = 0; j < 64; ++j) s += v[j];
            const float mu = s * (1.0f / 64.0f); float s2 = 0.f;
#pragma unroll
            for (int j = 0; j < 64; ++j) { v[j] -= mu; s2 += v[j] * v[j]; }
            const float rstd = rsqrtf(s2 * (1.0f / 64.0f) + LN_EPS);
#pragma unroll
            for (int j = 0; j < 8; ++j) { u32x4 w;
#pragma unroll
                for (int k = 0; k < 4; ++k) { const int e = j * 8 + 2 * k; w[k] = cvt_pk_bf16(v[e] * rstd * kn_g[e] + kn_b[e], v[e + 1] * rstd * kn_g[e + 1] + kn_b[e + 1]); }
                *(u32x4*)(KIB + (size_t)m * 64 + j * 8) = w; }
#pragma unroll
            for (int j = 0; j < 2; ++j) { const u32x4 w = *(const u32x4*)(KW + (size_t)m * 256 + 64 + j * 8);
                f32x4 a, b2; a[0] = bflo(w.x); a[1] = bfhi(w.x); a[2] = bflo(w.y); a[3] = bfhi(w.y); b2[0] = bflo(w.z); b2[1] = bfhi(w.z); b2[2] = bflo(w.w); b2[3] = bfhi(w.w);
                *(f32x4*)(WIF + (size_t)m * 16 + j * 8) = a; *(f32x4*)(WIF + (size_t)m * 16 + j * 8 + 4) = b2; }
        }
    }
    xcd_barrier(xbar);

    for (int rep_ = 0; rep_ < REP_P4; ++rep_) {
    for (int it0 = vcu; it0 < 256; it0 += G) {
        const int cc0 = it0 & 31, q16 = (it0 >> 5) & 3, b = it0 >> 7;
        for (int half = 0; half < 2; ++half) {
            const int c = half ? 63 - cc0 : cc0, nblk = c + 1, ntile = (nblk + 3) >> 2;
            const int m0 = b * SEQ + 64 * c + q16 * 16 + wave * 2;
            const int kk = lane & 15, quad = lane >> 4;
            bf16x8 a0[2], a1[2]; f32x4 w4[2];
#pragma unroll
            for (int qq = 0; qq < 2; ++qq) { const bf16_t* qp = QI + (size_t)(m0 + qq) * 1024 + kk * 64 + quad * 8;
                a0[qq] = *(const bf16x8*)(qp); a1[qq] = *(const bf16x8*)(qp + 32); w4[qq] = *(const f32x4*)(WIF + (size_t)(m0 + qq) * 16 + quad * 4); }
            const bf16_t* ksrc = KIB + (size_t)(b * SEQ) * 64 + (size_t)tid * 8;
            int kdst[4];
#pragma unroll
            for (int j = 0; j < 4; ++j) { const int q = tid + 512 * j, key = q >> 3, ch = q & 7; kdst[j] = key * 128 + ((ch ^ (key & 7)) << 4); }
            const int rd0 = kk * 128 + (((quad) ^ (kk & 7)) << 4), rd1 = kk * 128 + (((quad + 4) ^ (kk & 7)) << 4);
            u32x4 pf[4];
#pragma unroll
            for (int j = 0; j < 4; ++j) pf[j] = *(const u32x4*)(ksrc + (size_t)j * 4096);
#pragma unroll
            for (int j = 0; j < 4; ++j) *(LAS u32x4*)(lds + kdst[j]) = pf[j];
            if (ntile > 1) {
#pragma unroll
                for (int j = 0; j < 4; ++j) pf[j] = *(const u32x4*)(ksrc + (size_t)16384 + (size_t)j * 4096);
#pragma unroll
                for (int j = 0; j < 4; ++j) *(LAS u32x4*)(lds + 32768 + kdst[j]) = pf[j];
            }
            __syncthreads();
            unsigned* so0 = SCB + (size_t)m0 * SEQ + lane; unsigned* so1 = so0 + SEQ;
            for (int tile = 0; tile < ntile; ++tile) {
                const int buf = (tile % 3) * 32768;
                if (tile + 2 < ntile) {
#pragma unroll
                    for (int j = 0; j < 4; ++j) pf[j] = *(const u32x4*)(ksrc + (size_t)(tile + 2) * 16384 + (size_t)j * 4096); }
#pragma unroll
                for (int ii = 0; ii < 4; ++ii) {
                    const int i = 4 * tile + ii;
                    {
                        bf16x8 k0[4], k1[4];
#pragma unroll
                        for (int g = 0; g < 4; ++g) { const LAS unsigned char* kp = lds + buf + (64 * ii + 16 * g) * 128; k0[g] = *(const LAS bf16x8*)(kp + rd0); k1[g] = *(const LAS bf16x8*)(kp + rd1); }
#pragma unroll
                        for (int qq = 0; qq < 2; ++qq) {
                            f32x4 acc[4];
#pragma unroll
                            for (int g = 0; g < 4; ++g) { acc[g] = (f32x4){0.f, 0.f, 0.f, 0.f}; acc[g] = __builtin_amdgcn_mfma_f32_16x16x32_bf16(a0[qq], k0[g], acc[g], 0, 0, 0); }
#pragma unroll
                            for (int g = 0; g < 4; ++g) acc[g] = __builtin_amdgcn_mfma_f32_16x16x32_bf16(a1[qq], k1[g], acc[g], 0, 0, 0);
                            float v[4];
#pragma unroll
                            for (int g = 0; g < 4; ++g)
                                v[g] = w4[qq][0] * __builtin_amdgcn_fmed3f(acc[g][0], 0.f, INFINITY) + w4[qq][1] * __builtin_amdgcn_fmed3f(acc[g][1], 0.f, INFINITY)
                                     + w4[qq][2] * __builtin_amdgcn_fmed3f(acc[g][2], 0.f, INFINITY) + w4[qq][3] * __builtin_amdgcn_fmed3f(acc[g][3], 0.f, INFINITY);
                            const auto sA = __builtin_amdgcn_permlane16_swap(__float_as_uint(v[0]), __float_as_uint(v[1]), false, false);
                            const auto sB = __builtin_amdgcn_permlane16_swap(__float_as_uint(v[2]), __float_as_uint(v[3]), false, false);
                            const float t0 = __uint_as_float(sA[0]) + __uint_as_float(sA[1]), t1 = __uint_as_float(sB[0]) + __uint_as_float(sB[1]);
                            const auto sC = __builtin_amdgcn_permlane32_swap(__float_as_uint(t0), __float_as_uint(t1), false, false);
                            const float fin = __uint_as_float(sC[0]) + __uint_as_float(sC[1]);
                            const unsigned ub = __float_as_uint(fin);
                            const unsigned key = (ub & 0x80000000u) ? ~ub : (ub | 0x80000000u);
                            (qq ? so1 : so0)[64 * i] = key;
                        }
                    }
                }
                if (tile + 2 < ntile) { const int wb = ((tile + 2) % 3) * 32768;
#pragma unroll
                    for (int j = 0; j < 4; ++j) *(LAS u32x4*)(lds + wb + kdst[j]) = pf[j]; }
                __syncthreads();
            }
        }
    }
    xcd_barrier(xbar);
    }
    for (int rep_ = 0; rep_ < REP_P4B; ++rep_) {
    for (int wq = gw; wq < 2048; wq += NGW) {
        const int c0 = wq >> 5, jt = wq & 31;
        for (int r = 0; r < 4; ++r) {
            const int b = r & 1, hh = r >> 1, tok = jt + 32 * hh, c = hh ? 63 - c0 : c0;
            const int m = b * SEQ + 64 * c + tok, nblk = c + 1;
            unsigned long long myword = 0ull;
            if (nblk <= 4) {
                if (lane < nblk) myword = ~0ull;
            } else {
                unsigned sc[64];
                const unsigned* sp = SCB + (size_t)m * SEQ + lane;
#pragma unroll
                for (int g8 = 0; g8 < 8; ++g8) {
                    if (g8 * 8 < nblk) {
#pragma unroll
                        for (int e = 0; e < 8; ++e) { const int i = g8 * 8 + e; sc[i] = (i < nblk) ? sp[64 * i] : 0u; }
                    } else {
#pragma unroll
                        for (int e = 0; e < 8; ++e) sc[g8 * 8 + e] = 0u;
                    }
                }
                unsigned T = 0u; bool exact = false;
                for (int bit = 31; bit >= 0; --bit) {
                    const unsigned cand = T | (1u << bit);
                    int cnt = 0;
#pragma unroll
                    for (int g8 = 0; g8 < 8; ++g8) {
                        if (g8 * 8 < nblk) {
                            unsigned long long mk[8];
                            asm("v_cmp_le_u32_e64 %0, %8, %9\n\tv_cmp_le_u32_e64 %1, %8, %10\n\tv_cmp_le_u32_e64 %2, %8, %11\n\tv_cmp_le_u32_e64 %3, %8, %12\n\t"
                                "v_cmp_le_u32_e64 %4, %8, %13\n\tv_cmp_le_u32_e64 %5, %8, %14\n\tv_cmp_le_u32_e64 %6, %8, %15\n\tv_cmp_le_u32_e64 %7, %8, %16"
                                : "=&s"(mk[0]), "=&s"(mk[1]), "=&s"(mk[2]), "=&s"(mk[3]), "=&s"(mk[4]), "=&s"(mk[5]), "=&s"(mk[6]), "=&s"(mk[7])
                                : "v"(cand), "v"(sc[g8 * 8 + 0]), "v"(sc[g8 * 8 + 1]), "v"(sc[g8 * 8 + 2]), "v"(sc[g8 * 8 + 3]), "v"(sc[g8 * 8 + 4]), "v"(sc[g8 * 8 + 5]), "v"(sc[g8 * 8 + 6]), "v"(sc[g8 * 8 + 7]));
#pragma unroll
                            for (int e = 0; e < 8; ++e) cnt += __builtin_popcountll(mk[e]);
                        }
                    }
                    if (cnt >= 256) { T = cand; if (cnt == 256) { exact = true; break; } }
                }
                if (exact) {
#pragma unroll
                    for (int i = 0; i < 64; ++i) { const unsigned long long word = __ballot(sc[i] >= T); if (lane == i) myword = word; }
                } else {
                    int cgt = 0;
#pragma unroll
                    for (int i = 0; i < 64; ++i) cgt += __popcll(__ballot(sc[i] > T));
                    int need = 256 - cgt;
#pragma unroll
                    for (int i = 0; i < 64; ++i) {
                        const unsigned long long gt = __ballot(sc[i] > T), eq = __ballot(sc[i] == T);
                        unsigned long long sel = 0ull;
                        if (eq != 0ull && need > 0) {
                            const int ne = __popcll(eq);
                            if (ne <= need) { sel = eq; need -= ne; }
                            else { unsigned long long tmp = eq; for (int k = 0; k < need; ++k) { const unsigned long long low = tmp & (0ull - tmp); sel |= low; tmp ^= low; } need = 0; }
                        }
                        const unsigned long long word = gt | sel;
                        if (lane == i) myword = word;
                    }
                }
            }
            MASK[(size_t)m * 64 + lane] = myword;
        }
    }
    xcd_barrier(xbar);
    }

    for (int rep_ = 0; rep_ < REP_P5; ++rep_) {
    for (int it0 = vcu; it0 < 256; it0 += G) {
        const int cc0 = it0 & 31, n = (it0 >> 5) & 3, b = it0 >> 7;
        for (int half = 0; half < 2; ++half) {
            const int c = half ? 63 - cc0 : cc0, nblk = c + 1;
            const int h = lane >> 5, r = lane & 31;
            const int hq = 4 * n + (wave >> 1), th = wave & 1;
            const int mq = b * SEQ + 64 * c + 32 * th + r;
            bf16x8 qf[8];
            { const bf16_t* qp = Q + (size_t)mq * DM + hq * 128 + 8 * h;
#pragma unroll
              for (int ks = 0; ks < 8; ++ks) qf[ks] = *(const bf16x8*)(qp + ks * 16); }
            f32x16 o[4];
#pragma unroll
            for (int dt = 0; dt < 4; ++dt)
#pragma unroll
                for (int i = 0; i < 16; ++i) o[dt][i] = 0.f;
            float mrun = -INFINITY, lrun = 0.f;
            const int kq0 = tid, kq1 = tid + 512;
            const bf16_t* ksrc0 = KB + (size_t)(b * SEQ + (kq0 >> 4)) * 512 + n * 128 + (kq0 & 15) * 8;
            const bf16_t* ksrc1 = KB + (size_t)(b * SEQ + (kq1 >> 4)) * 512 + n * 128 + (kq1 & 15) * 8;
            const int kd0 = (kq0 >> 4) * 272 + (kq0 & 15) * 16, kd1 = (kq1 >> 4) * 272 + (kq1 & 15) * 16;
            const bf16_t* vsrc0 = VT + ((size_t)((b * 4 + n) * 128 + (kq0 >> 3))) * SEQ + (kq0 & 7) * 8;
            const bf16_t* vsrc1 = VT + ((size_t)((b * 4 + n) * 128 + (kq1 >> 3))) * SEQ + (kq1 & 7) * 8;
            const int vd0 = 17408 + (kq0 >> 3) * 136 + (kq0 & 7) * 16, vd1 = 17408 + (kq1 >> 3) * 136 + (kq1 & 7) * 16;
            u32x4 pk0, pk1, pv0, pv1;
            pk0 = *(const u32x4*)(ksrc0); pk1 = *(const u32x4*)(ksrc1); pv0 = *(const u32x4*)(vsrc0); pv1 = *(const u32x4*)(vsrc1);
            {
                *(LAS u32x4*)(lds + kd0) = pk0; *(LAS u32x4*)(lds + kd1) = pk1;
                *(LAS u32x2*)(lds + vd0) = (u32x2){pv0.x, pv0.y}; *(LAS u32x2*)(lds + vd0 + 8) = (u32x2){pv0.z, pv0.w};
                *(LAS u32x2*)(lds + vd1) = (u32x2){pv1.x, pv1.y}; *(LAS u32x2*)(lds + vd1 + 8) = (u32x2){pv1.z, pv1.w};
            }
            __syncthreads();
            const unsigned long long* mrow = MASK + (size_t)mq * 64;
            unsigned long long mwn = mrow[0];
            for (int kt = 0; kt < nblk; ++kt) {
                const int buf = (kt & 1) * 34816;
                const bool more = (kt + 1 < nblk);
                if (more) { const size_t ko = (size_t)(kt + 1) * 64 * 512, vo = (size_t)(kt + 1) * 64;
                    pk0 = *(const u32x4*)(ksrc0 + ko); pk1 = *(const u32x4*)(ksrc1 + ko); pv0 = *(const u32x4*)(vsrc0 + vo); pv1 = *(const u32x4*)(vsrc1 + vo); }
                const unsigned long long mw = mwn;
                if (more) mwn = mrow[kt + 1];
                f32x16 st[2];
#pragma unroll
                for (int sub = 0; sub < 2; ++sub) {
#pragma unroll
                    for (int i = 0; i < 16; ++i) st[sub][i] = 0.f;
                    const LAS unsigned char* kb = lds + buf + (32 * sub + r) * 272 + h * 16;
#pragma unroll
                    for (int k4 = 0; k4 < 2; ++k4) {
                        bf16x8 kf[4];
#pragma unroll
                        for (int ks = 0; ks < 4; ++ks) kf[ks] = *(const LAS bf16x8*)(kb + (4 * k4 + ks) * 32);
#pragma unroll
                        for (int ks = 0; ks < 4; ++ks) st[sub] = __builtin_amdgcn_mfma_f32_32x32x16_bf16(kf[ks], qf[4 * k4 + ks], st[sub], 0, 0, 0);
                        __builtin_amdgcn_sched_group_barrier(0x100, 4, 0); __builtin_amdgcn_sched_group_barrier(0x008, 4, 0);
                    }
                }
                constexpr float CSC = 0.08838834764831845f * 1.4426950408889634f;
                float mx = -INFINITY;
#pragma unroll
                for (int sub = 0; sub < 2; ++sub) { const unsigned w = (unsigned)(sub ? (mw >> 32) : (mw & 0xffffffffull)) >> (4 * h);
#pragma unroll
                    for (int i = 0; i < 16; ++i) { const int pos = (i & 3) + 8 * (i >> 2);
                        const float sv = ((w >> pos) & 1u) ? st[sub][i] * CSC : -INFINITY; st[sub][i] = sv; mx = fmaxf(mx, sv); } }
                { const auto sw = __builtin_amdgcn_permlane32_swap(__float_as_uint(mx), __float_as_uint(mx), false, false); mx = fmaxf(__uint_as_float(sw[0]), __uint_as_float(sw[1])); }
                const float mnew = fmaxf(mrun, mx), msafe = (mnew == -INFINITY) ? 0.f : mnew;
                const bool grow = __any(mnew > mrun);
                const float alpha = __builtin_amdgcn_exp2f(mrun - msafe);
                float ls = 0.f;
#pragma unroll
                for (int sub = 0; sub < 2; ++sub)
#pragma unroll
                    for (int i = 0; i < 16; ++i) { const float p = __builtin_amdgcn_exp2f(st[sub][i] - msafe); st[sub][i] = p; ls += p; }
                lrun = lrun * alpha + ls; mrun = mnew;
                if (grow) {
#pragma unroll
                    for (int dt = 0; dt < 4; ++dt)
#pragma unroll
                        for (int i = 0; i < 16; ++i) o[dt][i] *= alpha;
                }
#pragma unroll
                for (int sub = 0; sub < 2; ++sub)
#pragma unroll
                    for (int s = 0; s < 2; ++s) {
                        u32x4 pw; pw.x = cvt_pk_bf16(st[sub][8 * s + 0], st[sub][8 * s + 1]); pw.y = cvt_pk_bf16(st[sub][8 * s + 2], st[sub][8 * s + 3]);
                        pw.z = cvt_pk_bf16(st[sub][8 * s + 4], st[sub][8 * s + 5]); pw.w = cvt_pk_bf16(st[sub][8 * s + 6], st[sub][8 * s + 7]);
                        const bf16x8 pf = __builtin_bit_cast(bf16x8, pw);
                        u32x4 vw[4];
#pragma unroll
                        for (int dt = 0; dt < 4; ++dt) {
                            const LAS unsigned char* vp = lds + buf + 17408 + (32 * dt + r) * 136 + (32 * sub + 16 * s + 4 * h) * 2;
                            const u32x2 lo = *(const LAS u32x2*)(vp), hi = *(const LAS u32x2*)(vp + 16);
                            vw[dt] = (u32x4){lo.x, lo.y, hi.x, hi.y};
                        }
#pragma unroll
                        for (int dt = 0; dt < 4; ++dt) o[dt] = __builtin_amdgcn_mfma_f32_32x32x16_bf16(__builtin_bit_cast(bf16x8, vw[dt]), pf, o[dt], 0, 0, 0);
                        __builtin_amdgcn_sched_group_barrier(0x100, 8, 0); __builtin_amdgcn_sched_group_barrier(0x008, 4, 0);
                    }
                if (more) { const int nb2 = ((kt + 1) & 1) * 34816;
                    *(LAS u32x4*)(lds + nb2 + kd0) = pk0; *(LAS u32x4*)(lds + nb2 + kd1) = pk1;
                    *(LAS u32x2*)(lds + nb2 + vd0) = (u32x2){pv0.x, pv0.y}; *(LAS u32x2*)(lds + nb2 + vd0 + 8) = (u32x2){pv0.z, pv0.w};
                    *(LAS u32x2*)(lds + nb2 + vd1) = (u32x2){pv1.x, pv1.y}; *(LAS u32x2*)(lds + nb2 + vd1 + 8) = (u32x2){pv1.z, pv1.w}; }
                __syncthreads();
            }
            const float ltot = lrun + __shfl_xor(lrun, 32);
            const float inv = 1.0f / ltot;
            bf16_t* op = (rep_ + 1 < REP_P5 ? (bf16_t*)Z : Q) + (size_t)mq * DM + hq * 128 + 4 * h;
#pragma unroll
            for (int dt = 0; dt < 4; ++dt)
#pragma unroll
                for (int g4 = 0; g4 < 4; ++g4) {
                    u32x2 w; w.x = cvt_pk_bf16(o[dt][4 * g4 + 0] * inv, o[dt][4 * g4 + 1] * inv); w.y = cvt_pk_bf16(o[dt][4 * g4 + 2] * inv, o[dt][4 * g4 + 3] * inv);
                    *(u32x2*)(op + 32 * dt + 8 * g4) = w; }
        }
    }
    xcd_barrier(xbar);
    }

    {
        pg8::StaticOrder S; S.init(MT, DM, G, bx);
        pg8::Gemm g{CB, WA_T, MT, DM, DM, Q, WB_T}; EpiMerged E{GA, GB, U};
        pg8::gemm_phase<EpiMerged, true>(lds, g, S, E);
    }
    xcd_barrier(xbar);

    {
        pg8::Gemm g{U, WO_T, MT, DM, DM, nullptr, nullptr}; pg8::StaticOrder S; S.init(MT, DM, G, bx);
        EpiRes E{x, MOD + 2 * DM, Z};
        pg8::gemm_phase<EpiRes>(lds, g, S, E);
    }
    xcd_barrier(xbar);

    for (int m = gw; m < MT; m += NGW) {
        const int b = m >> 12;
        const float* zr = Z + (size_t)m * DM;
        f32x4 v[8]; float s = 0.f;
#pragma unroll
        for (int j = 0; j < 8; ++j) { v[j] = *(const f32x4*)(zr + j * 256 + lane * 4); s += (v[j][0] + v[j][1]) + (v[j][2] + v[j][3]); }
        const float mu = wave_sum(s) * (1.0f / DM); float s2 = 0.f;
#pragma unroll
        for (int j = 0; j < 8; ++j) { v[j] = v[j] - mu; s2 += (v[j][0] * v[j][0] + v[j][1] * v[j][1]) + (v[j][2] * v[j][2] + v[j][3] * v[j][3]); }
        const float rstd = rsqrtf(wave_sum(s2) * (1.0f / DM) + LN_EPS);
        const float* shf = MOD + (size_t)b * NMOD + 3 * DM; const float* scf = MOD + (size_t)b * NMOD + 4 * DM;
#pragma unroll
        for (int j = 0; j < 8; ++j) { const int col = j * 256 + lane * 4;
            const f32x4 gg = *(const f32x4*)(ln1_g + col), bb = *(const f32x4*)(ln1_b + col), sc4 = *(const f32x4*)(scf + col), sh4 = *(const f32x4*)(shf + col);
            f32x4 y, uu;
#pragma unroll
            for (int k = 0; k < 4; ++k) { y[k] = v[j][k] * rstd * gg[k] + bb[k]; uu[k] = y[k] * (1.0f + sc4[k]) + sh4[k]; }
            *(f32x4*)(X1 + (size_t)m * DM + col) = y;
            u32x2 w; w.x = cvt_pk_bf16(uu[0], uu[1]); w.y = cvt_pk_bf16(uu[2], uu[3]);
            *(u32x2*)(U + (size_t)m * DM + col) = w; }
    }
    xcd_barrier(xbar);

    {
        pg8::Gemm g{U, WUP_T, MT, 2 * DFF, DM, nullptr, nullptr}; pg8::StaticOrder S; S.init(MT, 2 * DFF, G, bx);
        EpiUp E{HG, SA, SG, conv_f};
        pg8::gemm_phase<EpiUp>(lds, g, S, E);
    }
    xcd_barrier(xbar);

    for (int un = gtid; un < 256 * (DFF / 4); un += NGT) {
        const int c4 = (un % (DFF / 4)) * 4, br = un / (DFF / 4), gi = br >> 1, lo = br & 1, row = gi * 64 + lo, t = row & (SEQ - 1);
        const f32x4 s0 = *(const f32x4*)(SA + ((size_t)(gi * 4 + 0)) * DFF + c4), s1 = *(const f32x4*)(SA + ((size_t)(gi * 4 + 1)) * DFF + c4),
                    s2 = *(const f32x4*)(SA + ((size_t)(gi * 4 + 2)) * DFF + c4), s3 = *(const f32x4*)(SA + ((size_t)(gi * 4 + 3)) * DFF + c4);
        const f32x4 gt = *(const f32x4*)(SG + ((size_t)(gi * 2 + lo)) * DFF + c4);
        const f32x4 w0 = *(const f32x4*)(conv_f + c4), w1 = *(const f32x4*)(conv_f + DFF + c4), w2 = *(const f32x4*)(conv_f + 2 * DFF + c4);
        float y[4];
#pragma unroll
        for (int j = 0; j < 4; ++j) {
            const float a0 = lo ? s3[j] : s2[j];
            float a1 = lo ? s2[j] : s1[j], a2 = lo ? s1[j] : s0[j];
            if (t < 1) a1 = 0.f;
            if (t < 2) a2 = 0.f;
            y[j] = gelu_tanh_(w0[j] * a2 + w1[j] * a1 + w2[j] * a0) * gt[j];
        }
        u32x2 w; w.x = cvt_pk_bf16(y[0], y[1]); w.y = cvt_pk_bf16(y[2], y[3]);
        *(u32x2*)(HG + (size_t)row * DFF + c4) = w;
    }
    xcd_barrier(xbar);

    {
        pg8::Gemm g{HG, WD_T, MT, DM, DFF, nullptr, nullptr}; pg8::StaticOrder S; S.init(MT, DM, G, bx);
        EpiRes E{X1, MOD + 5 * DM, Z2};
        pg8::gemm_phase<EpiRes>(lds, g, S, E);
    }
    xcd_barrier(xbar);

    for (int m = gw; m < MT; m += NGW) {
        const float* zr = Z2 + (size_t)m * DM;
        f32x4 v[8]; float s = 0.f;
#pragma unroll
        for (int j = 0; j < 8; ++j) { v[j] = *(const f32x4*)(zr + j * 256 + lane * 4); s += (v[j][0] + v[j][1]) + (v[j][2] + v[j][3]); }
        const float mu = wave_sum(s) * (1.0f / DM); float s2 = 0.f;
#pragma unroll
        for (int j = 0; j < 8; ++j) { v[j] = v[j] - mu; s2 += (v[j][0] * v[j][0] + v[j][1] * v[j][1]) + (v[j][2] * v[j][2] + v[j][3] * v[j][3]); }
        const float rstd = rsqrtf(wave_sum(s2) * (1.0f / DM) + LN_EPS);
#pragma unroll
        for (int j = 0; j < 8; ++j) { const int col = j * 256 + lane * 4;
            const f32x4 gg = *(const f32x4*)(ln2_g + col), bb = *(const f32x4*)(ln2_b + col);
            f32x4 y;
#pragma unroll
            for (int k = 0; k < 4; ++k) y[k] = v[j][k] * rstd * gg[k] + bb[k];
            *(f32x4*)(out + (size_t)m * DM + col) = y; }
    }
}

extern "C" void kernel_launch(void* const* d_in, const int* in_sizes, int n_in, void* d_out, int out_size, void* d_ws, size_t ws_size, hipStream_t stream) {
    static int grid_blocks = 0;
    if (grid_blocks == 0) {
        if (n_in != 18 || ws_size < WS_END) { fprintf(stderr, "kernel_launch: unexpected n_in %d or ws_size %zu (< %zu)\n", n_in, ws_size, (size_t)WS_END); grid_blocks = -1; return; }
        int dev = 0, cus = 0, per_cu = 0;
        hipGetDevice(&dev);
        hipDeviceGetAttribute(&cus, hipDeviceAttributeMultiprocessorCount, dev);
        if (hipFuncSetAttribute((const void*)fwd_megakernel, hipFuncAttributeMaxDynamicSharedMemorySize, LDS_BYTES) != hipSuccess) { fprintf(stderr, "kernel_launch: hipFuncSetAttribute failed\n"); grid_blocks = -1; return; }
        hipOccupancyMaxActiveBlocksPerMultiprocessor(&per_cu, (const void*)fwd_megakernel, NTHR, LDS_BYTES);
        if (per_cu < 1) { fprintf(stderr, "kernel_launch: occupancy query says %d\n", per_cu); per_cu = 1; }
        (void)hipGetLastError();
        grid_blocks = cus * per_cu;
    }
    if (grid_blocks < 0) return;
    Args a{};
    for (int i = 0; i < 18; ++i) a.in[i] = (const float*)d_in[i];
    a.out = (float*)d_out; a.ws = (unsigned char*)d_ws;
    void* kargs[] = {&a};
    hipError_t e = hipLaunchCooperativeKernel((const void*)fwd_megakernel, dim3(grid_blocks), dim3(NTHR), kargs, LDS_BYTES, stream);
    if (e != hipSuccess) fprintf(stderr, "cooperative launch failed: %s (grid %d)\n", hipGetErrorString(e), grid_blocks);
}
```
